# Optimizing an MI355X kernel written in HIP

```python
import jax, jax.numpy as jnp
from jax import lax
import numpy as np

D_MODEL = 1024
BATCH = 32
SEQ = 2048
DEPTH = 1
DEC_BATCH = 8
DEC_SEQ = 4096
PAST_LEN = 128

HEAD_DIM = 128
A_Q_HEADS = 8
A_KV_HEADS = 2
A_HALF_WINDOW = 128
A_BLOCK = 128
B_GROUPS = ((128, 1), (512, 4), (2048, 16))
B_HEADS = 4
B_BLOCK = 64
D_FF = 4 * D_MODEL
ROPE_THETA = 10000.0
EPS = 1e-6
NEG = -1e30

A_Q = A_Q_HEADS * HEAD_DIM
A_KV = A_KV_HEADS * HEAD_DIM
B_W = B_HEADS * HEAD_DIM
N_B = len(B_GROUPS)
D_IN = A_Q + 2 * A_KV + 3 * N_B * B_W + 2 * D_MODEL

kernel_name = "hybrid_window_dilated_encoder"


def rmsnorm(x, g):
    xf = x.astype(jnp.float32)
    y = xf * lax.rsqrt(jnp.mean(xf * xf, axis=-1, keepdims=True) + EPS)
    return (y * g.astype(jnp.float32)).astype(x.dtype)


def rope(t, pos):
    half = t.shape[-1] // 2
    inv = jnp.power(ROPE_THETA, -jnp.arange(half, dtype=jnp.float32) / half)
    ang = pos.astype(jnp.float32)[:, None] * inv[None, :]
    cos = jnp.cos(ang)[None, :, None, :]
    sin = jnp.sin(ang)[None, :, None, :]
    tf = t.astype(jnp.float32)
    t1, t2 = tf[..., :half], tf[..., half:]
    return jnp.concatenate([t1 * cos - t2 * sin, t1 * sin + t2 * cos], axis=-1).astype(t.dtype)


def banded_attention(q, k, v, half_window, block, sink=None):
    bsz, L, H, hd = q.shape
    hkv = k.shape[2]
    grp = H // hkv
    nb = -(-L // block)
    Lp = nb * block
    pad = Lp - L
    q = jnp.pad(q * (hd ** -0.5), ((0, 0), (0, pad), (0, 0), (0, 0)))
    k = jnp.pad(k, ((0, 0), (block, block + pad), (0, 0), (0, 0)))
    v = jnp.pad(v, ((0, 0), (block, block + pad), (0, 0), (0, 0)))
    qb = q.reshape(bsz, nb, block, hkv, grp, hd)

    def bands(t):
        t = t.reshape(bsz, nb + 2, block, hkv, hd)
        return jnp.concatenate([t[:, :-2], t[:, 1:-1], t[:, 2:]], axis=2)

    kb, vb = bands(k), bands(v)
    s = jnp.einsum('bnqhgd,bnkhd->bnhgqk', qb, kb).astype(jnp.float32)
    qpos = jnp.arange(Lp).reshape(nb, block, 1)
    kpos = (jnp.arange(nb)[:, None, None] - 1) * block + jnp.arange(3 * block)[None, None, :]
    mask = (jnp.abs(kpos - qpos) <= half_window) & (kpos >= 0) & (kpos < L)
    s = jnp.where(mask[None, :, None, None], s, NEG)
    m = jnp.max(s, axis=-1)
    if sink is not None:
        sk = sink.astype(jnp.float32).reshape(hkv, grp)[None, None, :, :, None]
        m = jnp.maximum(m, sk)
    p = jnp.exp(s - m[..., None])
    den = jnp.sum(p, axis=-1)
    if sink is not None:
        den = den + jnp.exp(sk - m)
    o = jnp.einsum('bnhgqk,bnkhd->bnqhgd', p, vb.astype(jnp.float32))
    o = o / jnp.transpose(den, (0, 1, 4, 2, 3))[..., None]
    o = o.reshape(bsz, Lp, H, hd)[:, :L].astype(v.dtype)
    lse = jnp.transpose(m + jnp.log(den), (0, 1, 4, 2, 3)).reshape(bsz, Lp, H)[:, :L]
    return o, lse


def dilated_attention(q, k, v, window, dilation):
    bsz, L, H, hd = q.shape
    Ld = L // dilation

    def fold(t):
        return jnp.transpose(t.reshape(bsz, Ld, dilation, H, hd), (0, 2, 1, 3, 4)).reshape(bsz * dilation, Ld, H, hd)

    o, lse = banded_attention(fold(q), fold(k), fold(v), (window // 2) // dilation, B_BLOCK)
    o = jnp.transpose(o.reshape(bsz, dilation, Ld, H, hd), (0, 2, 1, 3, 4)).reshape(bsz, L, H, hd)
    lse = jnp.transpose(lse.reshape(bsz, dilation, Ld, H), (0, 2, 1, 3)).reshape(bsz, L, H)
    return o, lse


def encoder_layer(x, w_in, sink, w_a, w_b, w_o, g_pre_mix, g_post_mix, g_pre_mlp, g_post_mlp, w_1, w_2):
    bsz, L, _ = x.shape
    pos = jnp.arange(L)
    h = rmsnorm(x, g_pre_mix)
    z = h @ w_in
    widths = [A_Q, A_KV, A_KV] + [B_W] * (3 * N_B) + [D_MODEL]
    parts = jnp.split(z, [int(c) for c in np.cumsum(widths)], axis=-1)

    qa = rope(parts[0].reshape(bsz, L, A_Q_HEADS, HEAD_DIM), pos)
    ka = rope(parts[1].reshape(bsz, L, A_KV_HEADS, HEAD_DIM), pos)
    va = parts[2].reshape(bsz, L, A_KV_HEADS, HEAD_DIM)
    oa, _ = banded_attention(qa, ka, va, A_HALF_WINDOW, A_BLOCK, sink)
    ya = oa.reshape(bsz, L, A_Q) @ w_a

    outs, lses = [], []
    for g, (window, dilation) in enumerate(B_GROUPS):
        qg = rope(parts[3 + 3 * g].reshape(bsz, L, B_HEADS, HEAD_DIM), pos)
        kg = rope(parts[4 + 3 * g].reshape(bsz, L, B_HEADS, HEAD_DIM), pos)
        vg = parts[5 + 3 * g].reshape(bsz, L, B_HEADS, HEAD_DIM)
        o, lse = dilated_attention(qg, kg, vg, window, dilation)
        outs.append(o)
        lses.append(lse)
    wts = jax.nn.softmax(jnp.stack(lses), axis=0)
    ob = jnp.sum(wts[..., None] * jnp.stack(outs).astype(jnp.float32), axis=0).astype(x.dtype)
    yb = ob.reshape(bsz, L, B_W) @ w_b

    gate_a, gate_b = parts[-2], parts[-1]
    mix = (jax.nn.sigmoid(gate_a) * ya + jax.nn.sigmoid(gate_b) * yb) @ w_o
    x = x + rmsnorm(mix, g_post_mix)

    u = jax.nn.relu(rmsnorm(x, g_pre_mlp) @ w_1)
    x = x + rmsnorm((u * u) @ w_2, g_post_mlp)
    return x


def trunk(x, w_in, sink, w_a, w_b, w_o, g_pre_mix, g_post_mix, g_pre_mlp, g_post_mlp, w_1, w_2):
    for l in range(DEPTH):
        x = encoder_layer(x, w_in[l], sink[l], w_a[l], w_b[l], w_o[l], g_pre_mix[l], g_post_mix[l],
                          g_pre_mlp[l], g_post_mlp[l], w_1[l], w_2[l])
    return x


def setup_inputs(seed: int = 0) -> dict:
    key = jax.random.key(seed)
    ks = jax.random.split(key, 14)
    f32 = jnp.float32

    def nrm(k, shape, scale):
        return jax.random.normal(k, shape, f32) * scale

    return {
        "x_prompt": nrm(ks[0], (BATCH, SEQ, D_MODEL), 1.0),
        "x_sample": nrm(ks[1], (DEC_BATCH, DEC_SEQ, D_MODEL), 1.0),
        "w_in": nrm(ks[2], (DEPTH, D_MODEL, D_IN), D_MODEL ** -0.5),
        "sink": nrm(ks[3], (DEPTH, A_Q_HEADS), 0.5),
        "w_a": nrm(ks[4], (DEPTH, A_Q, D_MODEL), A_Q ** -0.5),
        "w_b": nrm(ks[5], (DEPTH, B_W, D_MODEL), B_W ** -0.5),
        "w_o": nrm(ks[6], (DEPTH, D_MODEL, D_MODEL), D_MODEL ** -0.5),
        "g_pre_mix": 1.0 + nrm(ks[7], (DEPTH, D_MODEL), 0.1),
        "g_post_mix": 1.0 + nrm(ks[8], (DEPTH, D_MODEL), 0.1),
        "g_pre_mlp": 1.0 + nrm(ks[9], (DEPTH, D_MODEL), 0.1),
        "g_post_mlp": 1.0 + nrm(ks[10], (DEPTH, D_MODEL), 0.1),
        "w_1": nrm(ks[11], (DEPTH, D_MODEL, D_FF), D_MODEL ** -0.5),
        "w_2": nrm(ks[12], (DEPTH, D_FF, D_MODEL), D_FF ** -0.5),
    }


def reference(x_prompt, x_sample, w_in, sink, w_a, w_b, w_o, g_pre_mix, g_post_mix, g_pre_mlp, g_post_mlp, w_1, w_2):
    y_prompt = trunk(x_prompt, w_in, sink, w_a, w_b, w_o, g_pre_mix, g_post_mix, g_pre_mlp, g_post_mlp, w_1, w_2)
    y_sample = trunk(x_sample, w_in, sink, w_a, w_b, w_o, g_pre_mix, g_post_mix, g_pre_mlp, g_post_mlp, w_1, w_2)
    return (y_prompt, y_sample)
```

```cpp
#include <hip/hip_runtime.h>
#include <hip/hip_cooperative_groups.h>
#include <cstdio>
#include <cstdint>
namespace cg = cooperative_groups;
namespace pg8 {
#define PG8_LAS __attribute__((address_space(3)))
typedef unsigned short bf16_t;
typedef short bf16x8 __attribute__((ext_vector_type(8)));
typedef float f32x4 __attribute__((ext_vector_type(4)));
typedef unsigned u32x4 __attribute__((ext_vector_type(4)));
constexpr int BM = 256, BK = 64, HALF = 128, HTB = HALF * BK * 2  , STAGE_BYTES = 8 * HTB, NXCD = 8, WGM = 8;

__host__ __device__ __forceinline__ int lds_byte(int r, int c) { const int st = (r >> 4) * 2 + (c >> 5), rr = r & 15, cc = c & 31, ob = rr * 64 + cc * 2; return st * 1024 + (ob ^ (((ob >> 9) & 1) << 5)); }
__host__ __device__ __forceinline__ void stage_rc(int b, int& R, int& C) { const int st = b / 1024, sb = b % 1024, swz = sb ^ (((sb >> 9) & 1) << 5); R = (st >> 1) * 16 + swz / 64; C = (st & 1) * 32 + (swz % 64) / 2; }
__host__ __device__ __forceinline__ int perm32(int rho) { const int n = rho >> 4, i = rho & 15; return 8 * (i >> 2) + 4 * n + (i & 3); }

struct Unit { int pm, pn; };
struct Gemm { const bf16_t* A; const bf16_t* Bt; int M, N, K; };

struct StaticOrder {
    int nM, nN, nwg, G, c, wgm = WGM;
    __host__ __device__ void init(int M, int N, int G_, int c_) { nM = M / BM; nN = N / BM; nwg = nM * nN; G = G_; c = c_; }
    __host__ __device__ bool next(int i, Unit& u) const {
        const long L = (long)i * G + c; if (L >= nwg) return false;
        int wgid = (int)L; { const int q = nwg / NXCD, r = nwg % NXCD, xcd = wgid % NXCD, off = wgid / NXCD; wgid = (xcd < r ? xcd * (q + 1) : r * (q + 1) + (xcd - r) * q) + off; }
        const int nig = wgm * nN, gid = wgid / nig, fm = gid * wgm, gsz = (nM - fm) < wgm ? (nM - fm) : wgm;
        u.pm = fm + ((wgid % nig) % gsz); u.pn = (wgid % nig) / gsz; return true;
    }
    __device__ __forceinline__ void a_ready(const Unit&) const {}
    __device__ __forceinline__ void done(const Unit&) const {}
};

__device__ __forceinline__ unsigned cvt_pk_bf16(float lo, float hi) { unsigned r; asm volatile("v_cvt_pk_bf16_f32 %0, %1, %2" : "=v"(r) : "v"(lo), "v"(hi)); return r; }
typedef unsigned u32x2 __attribute__((ext_vector_type(2)));
constexpr size_t ZH = (size_t)32768 * 128;
__device__ __forceinline__ float bf_lo(unsigned w) { return __builtin_bit_cast(float, w << 16); }
__device__ __forceinline__ float bf_hi(unsigned w) { return __builtin_bit_cast(float, w & 0xffff0000u); }
__device__ __forceinline__ float sigm(float x) { return __builtin_amdgcn_rcpf(1.0f + __builtin_amdgcn_exp2f(-1.4426950408889634f * x)); }
template <int MODE> struct Epi {
    static constexpr bool PERM = true, AFTER_DRAIN = false;
    static constexpr int HOOK_T = (MODE == 1) ? 16 : 0;
    __device__ __forceinline__ void hook(f32x4 (&acc)[2][2][4][2], const Unit& u, int wr, int wc, int fr, int fq) const {
        if constexpr (MODE == 1) {
            int fr_ = fr, fq_ = fq; asm volatile("" : "+v"(fr_), "+v"(fq_));
            const int row0 = u.pm * BM + wr * 64 + fr_, col0 = u.pn * BM + wc * 32 + 8 * fq_;
#pragma unroll
            for (int ai = 0; ai < 2; ++ai)
#pragma unroll
            for (int m = 0; m < 4; ++m) {
                u32x4 ga[2], gb[2];
#pragma unroll
                for (int bj = 0; bj < 2; ++bj) { const bf16_t* p = Zg + (size_t)(2 * u.pn + bj) * ZH + (size_t)(row0 + ai * HALF + m * 16) * 128 + (col0 & 127);
                    gb[bj] = *(const u32x4*)p; ga[bj] = *(const u32x4*)(p - 8 * ZH); }
                asm volatile("" ::: "memory");
#pragma unroll
                for (int bj = 0; bj < 2; ++bj) { const u32x4 a = ga[bj], b = gb[bj];
#define RAT(x, y) ((1.0f + __builtin_amdgcn_exp2f(-1.4426950408889634f * (y))) * __builtin_amdgcn_rcpf(1.0f + __builtin_amdgcn_exp2f(-1.4426950408889634f * (x))))
                    f32x4& v0 = acc[ai][bj][m][0]; f32x4& v1 = acc[ai][bj][m][1];
                    v0[0] *= RAT(bf_lo(a.x), bf_lo(b.x)); v0[1] *= RAT(bf_hi(a.x), bf_hi(b.x)); v0[2] *= RAT(bf_lo(a.y), bf_lo(b.y)); v0[3] *= RAT(bf_hi(a.y), bf_hi(b.y));
                    v1[0] *= RAT(bf_lo(a.z), bf_lo(b.z)); v1[1] *= RAT(bf_hi(a.z), bf_hi(b.z)); v1[2] *= RAT(bf_lo(a.w), bf_lo(b.w)); v1[3] *= RAT(bf_hi(a.w), bf_hi(b.w));
#undef RAT
                }
                asm volatile("" ::: "memory");
            }
        }
    }
    bf16_t* O; int ldc; const bf16_t* Zg; const float* ropeC; const float* ropeS; int lmask; float qscale;
    __device__ __forceinline__ void operator()(const f32x4 (&acc)[2][2][4][2], const Unit& u, int wr, int wc, int fr, int fq) const {
        const int row0 = u.pm * BM + wr * 64 + fr;
        const int col0 = u.pn * BM + wc * 32 + 8 * fq;
        if constexpr (MODE == 0) {
            const int pn = u.pn; const bool isg = (pn >= 6 && pn < 24); const int gm = isg ? (pn - 6) % 6 : 0;
            const bool rope_on = (pn <= 4) || (isg && gm < 4); const bool q_on = (pn < 4) || (isg && gm < 2);
            if (rope_on) {
                const float sc = q_on ? qscale : 1.0f; const int j0 = 16 * wc + 4 * fq;
                float wj[4];
#pragma unroll
                for (int i = 0; i < 4; ++i) wj[i] = __builtin_amdgcn_exp2f(-(float)(j0 + i) * (13.287712379549449f / 64.0f)) * 0.15915494309189535f;
#pragma unroll
                for (int ai = 0; ai < 2; ++ai)
#pragma unroll
                    for (int m = 0; m < 4; ++m) {
                        const int r = row0 + ai * HALF + m * 16; const float pos = (float)(r & lmask);
                        f32x4 c, s;
#pragma unroll
                        for (int i = 0; i < 4; ++i) { const float x = __builtin_amdgcn_fractf(pos * wj[i]); c[i] = __builtin_amdgcn_cosf(x) * sc; s[i] = __builtin_amdgcn_sinf(x) * sc; }
#pragma unroll
                        for (int bj = 0; bj < 2; ++bj) {
                            const f32x4 t1 = acc[ai][bj][m][0], t2 = acc[ai][bj][m][1];
                            const f32x4 o1 = t1 * c - t2 * s, o2 = t1 * s + t2 * c;
                            bf16_t* p = O + (size_t)(2 * pn + bj) * ZH + (size_t)r * 128 + (col0 & 127);
                            u32x4 w; w.x = cvt_pk_bf16(o1[0], o1[1]); w.y = cvt_pk_bf16(o1[2], o1[3]); w.z = cvt_pk_bf16(o2[0], o2[1]); w.w = cvt_pk_bf16(o2[2], o2[3]);
                            __builtin_nontemporal_store(w, (u32x4*)p);
                        }
                    }
                return;
            }
        }
        constexpr int MB = (MODE == 2) ? 2 : 4;
#pragma unroll
        for (int ai = 0; ai < 2; ++ai)
#pragma unroll
        for (int mb = 0; mb < 4; mb += MB) {
            u32x4 gt[MB][2], og[MB][2];
            if constexpr (MODE == 1 || MODE == 2) {
#pragma unroll
                for (int m = 0; m < MB; ++m)
#pragma unroll
                    for (int bj = 0; bj < 2; ++bj) { const int r = row0 + ai * HALF + (mb + m) * 16;
                        gt[m][bj] = *(const u32x4*)(Zg + (size_t)(2 * u.pn + bj) * ZH + (size_t)r * 128 + (col0 & 127));
                        if constexpr (MODE == 2) og[m][bj] = *(const u32x4*)(O + (size_t)r * ldc + col0 + bj * HALF); }
                asm volatile("" ::: "memory");
            }
#pragma unroll
            for (int mm = 0; mm < MB; ++mm) {
                const int m = mb + mm;
                const int r = row0 + ai * HALF + m * 16;
#pragma unroll
                for (int bj = 0; bj < 2; ++bj) {
                    f32x4 v0 = acc[ai][bj][m][0], v1 = acc[ai][bj][m][1];
                    bf16_t* p = (MODE == 0) ? O + (size_t)(2 * u.pn + bj) * ZH + (size_t)r * 128 + (col0 & 127) : O + (size_t)r * ldc + col0 + bj * HALF;
                    if constexpr (MODE == 1 || MODE == 2) {
                        const u32x4 g = gt[mm][bj];
                        v0[0] *= sigm(bf_lo(g.x)); v0[1] *= sigm(bf_hi(g.x)); v0[2] *= sigm(bf_lo(g.y)); v0[3] *= sigm(bf_hi(g.y));
                        v1[0] *= sigm(bf_lo(g.z)); v1[1] *= sigm(bf_hi(g.z)); v1[2] *= sigm(bf_lo(g.w)); v1[3] *= sigm(bf_hi(g.w));
                        if constexpr (MODE == 2) {
                            const u32x4 o = og[mm][bj];
                            v0[0] += bf_lo(o.x); v0[1] += bf_hi(o.x); v0[2] += bf_lo(o.y); v0[3] += bf_hi(o.y);
                            v1[0] += bf_lo(o.z); v1[1] += bf_hi(o.z); v1[2] += bf_lo(o.w); v1[3] += bf_hi(o.w);
                        }
                    }
                    if constexpr (MODE == 4) {
#pragma unroll
                        for (int i = 0; i < 4; ++i) { const float a = fmaxf(v0[i], 0.f), b = fmaxf(v1[i], 0.f); v0[i] = a * a; v1[i] = b * b; }
                    }
                    u32x4 w; w.x = cvt_pk_bf16(v0[0], v0[1]); w.y = cvt_pk_bf16(v0[2], v0[3]); w.z = cvt_pk_bf16(v1[0], v1[1]); w.w = cvt_pk_bf16(v1[2], v1[3]);
                    if constexpr (MODE == 0) __builtin_nontemporal_store(w, (u32x4*)p); else *(u32x4*)p = w;
                }
            }
        }
    }
};
template <class Epi, class Sched, bool ALIGN_EPI = false, bool SP2 = false>
__device__ __forceinline__ void gemm_phase(PG8_LAS unsigned char* lds, const Gemm g, const Sched& S, const Epi& E) {
    int tid_ = threadIdx.x; asm volatile("" : "+v"(tid_));
    const int tid = tid_, wid = __builtin_amdgcn_readfirstlane(tid >> 6), lane = tid & 63, wr = wid >> 2, wc = wid & 3, fr = lane & 15, fq = lane >> 4;
    const int K = g.K, nt = K / BK;
    unsigned voffA[2], voffB[2];
#pragma unroll
    for (int i = 0; i < 2; ++i) { int R, C; stage_rc(tid * 16 + i * 8192, R, C); const int Rb = Epi::PERM ? ((R & ~31) + perm32(R & 31)) : R;
        voffA[i] = (unsigned)(R * K + C) * 2u; voffB[i] = (unsigned)(Rb * K + C) * 2u; }
    const size_t kstep = (size_t)(BK * 2);
    const size_t hstep = (size_t)HALF * K * 2;
    const size_t tstep = 2 * hstep;
    const unsigned ldsw = (unsigned)wid * 1024u;
    const int aoff = lds_byte(wr * 64 + fr, fq * 8), boff = lds_byte(wc * 32 + fr, fq * 8);
#define PG8_SA(b, h) (((b) * 2 + (h)) * HTB)
#define PG8_SB(b, h) ((4 + (b) * 2 + (h)) * HTB)
#define PG8_STAGE(bufoff, gbase, voff) do { _Pragma("unroll") for (int _i = 0; _i < 2; ++_i) \
        __builtin_amdgcn_global_load_lds((const unsigned*)((const char*)(gbase) + (voff)[_i]), (PG8_LAS unsigned*)(lds + (bufoff) + ldsw + _i * 8192), 16, 0, 0); } while (0)
#define PG8_LDA(dst, b, h) do { _Pragma("unroll") for (int m = 0; m < 4; ++m) _Pragma("unroll") for (int k = 0; k < 2; ++k) dst[m][k] = *(const PG8_LAS bf16x8*)(lds + PG8_SA(b, h) + aoff + m * 2048 + k * 1024); } while (0)
#define PG8_LDB(dst, b, h) do { _Pragma("unroll") for (int n = 0; n < 2; ++n) _Pragma("unroll") for (int k = 0; k < 2; ++k) dst[n][k] = *(const PG8_LAS bf16x8*)(lds + PG8_SB(b, h) + boff + n * 2048 + k * 1024); } while (0)
#define PG8_MMA(ai, bj, At, Bt) do { __builtin_amdgcn_s_setprio(1); _Pragma("unroll") for (int m = 0; m < 4; ++m) _Pragma("unroll") for (int n = 0; n < 2; ++n) _Pragma("unroll") for (int k = 0; k < 2; ++k) \
        acc[ai][bj][m][n] = __builtin_amdgcn_mfma_f32_16x16x32_bf16(Bt[n][k], At[m][k], acc[ai][bj][m][n], 0, 0, 0); __builtin_amdgcn_s_setprio(0); } while (0)
#define PG8_WAIT_V(n) asm volatile("s_waitcnt vmcnt(" #n ")" ::: "memory")
#define PG8_WAIT_L(n) asm volatile("s_waitcnt lgkmcnt(" #n ")" ::: "memory")
#define PG8_BAR __builtin_amdgcn_s_barrier()
#define PG8_SCHED __builtin_amdgcn_sched_barrier(0)
    Unit cur, nxt; int ui = 0;
    if (!S.next(0, cur)) return;
    f32x4 acc[2][2][4][2];
#pragma unroll
    for (int a = 0; a < 2; ++a)
#pragma unroll
        for (int b = 0; b < 2; ++b)
#pragma unroll
            for (int m = 0; m < 4; ++m)
#pragma unroll
                for (int n = 0; n < 2; ++n) acc[a][b][m][n] = (f32x4){0.f, 0.f, 0.f, 0.f};
    bf16x8 At[4][2], B0[2][2], B1[2][2];
    const char* cA = (const char*)g.A + (size_t)cur.pm * tstep; const char* cB = (const char*)g.Bt + (size_t)cur.pn * tstep;
    S.a_ready(cur);
    if constexpr (SP2) {
        PG8_STAGE(PG8_SB(0, 0), cB, voffB); PG8_STAGE(PG8_SB(0, 1), cB + hstep, voffB); PG8_STAGE(PG8_SA(0, 0), cA, voffA); PG8_STAGE(PG8_SA(0, 1), cA + hstep, voffA);
        if (wr == 1) PG8_BAR;
        PG8_WAIT_V(2); PG8_BAR;
        PG8_STAGE(PG8_SB(1, 0), cB + kstep, voffB); PG8_STAGE(PG8_SA(1, 0), cA + kstep, voffA); PG8_STAGE(PG8_SB(1, 1), cB + hstep + kstep, voffB);
        PG8_WAIT_V(6); PG8_BAR;
    } else {
        PG8_STAGE(PG8_SB(0, 0), cB, voffB); PG8_STAGE(PG8_SA(0, 0), cA, voffA); PG8_STAGE(PG8_SB(0, 1), cB + hstep, voffB); PG8_STAGE(PG8_SA(0, 1), cA + hstep, voffA);
        if (wr == 1) PG8_BAR;
        PG8_WAIT_V(4); PG8_BAR;
        PG8_STAGE(PG8_SB(1, 0), cB + kstep, voffB); PG8_STAGE(PG8_SA(1, 0), cA + kstep, voffA); PG8_STAGE(PG8_SB(1, 1), cB + hstep + kstep, voffB);
        PG8_WAIT_V(6); PG8_BAR;
    }
    for (;;) {
        const bool has_next = S.next(ui + 1, nxt);
        const char* nA = has_next ? (const char*)g.A + (size_t)nxt.pm * tstep : cA; const char* nB = has_next ? (const char*)g.Bt + (size_t)nxt.pn * tstep : cB;
        for (int t = 0; t < nt; t += 2) {
            const bool last = (t == nt - 2);
            const char* a1 = cA + (size_t)(t + 1) * kstep;
            const char* a2 = last ? nA : cA + (size_t)(t + 2) * kstep; const char* b2 = last ? nB : cB + (size_t)(t + 2) * kstep;
            const char* a3 = a2 + kstep; const char* b3 = b2 + kstep;
            if (last && has_next) S.a_ready(nxt);
            if constexpr (Epi::HOOK_T > 0) { if (t == Epi::HOOK_T) E.hook(acc, cur, wr, wc, fr, fq); }
            if constexpr (SP2) {
            PG8_LDB(B0, 0, 0); PG8_LDB(B1, 0, 1); PG8_SCHED; PG8_LDA(At, 0, 0); PG8_STAGE(PG8_SA(1, 1), a1 + hstep, voffA);
            PG8_WAIT_V(8); PG8_WAIT_L(0); PG8_BAR; PG8_MMA(0, 0, At, B0); PG8_MMA(0, 1, At, B1); PG8_BAR; PG8_SCHED;
            PG8_LDA(At, 0, 1); PG8_STAGE(PG8_SB(0, 0), b2, voffB); PG8_STAGE(PG8_SB(0, 1), b2 + hstep, voffB); PG8_STAGE(PG8_SA(0, 0), a2, voffA);
            PG8_WAIT_V(8); PG8_WAIT_L(0); PG8_BAR; PG8_MMA(1, 0, At, B0); PG8_MMA(1, 1, At, B1); PG8_BAR; PG8_SCHED;
            PG8_LDB(B0, 1, 0); PG8_LDB(B1, 1, 1); PG8_SCHED; PG8_LDA(At, 1, 0); PG8_STAGE(PG8_SA(0, 1), a2 + hstep, voffA);
            PG8_WAIT_V(8); PG8_WAIT_L(0); PG8_BAR; PG8_MMA(0, 0, At, B0); PG8_MMA(0, 1, At, B1); PG8_BAR; PG8_SCHED;
            PG8_LDA(At, 1, 1); PG8_STAGE(PG8_SB(1, 0), b3, voffB); PG8_STAGE(PG8_SB(1, 1), b3 + hstep, voffB); PG8_STAGE(PG8_SA(1, 0), a3, voffA);
            PG8_WAIT_V(8); PG8_WAIT_L(0); PG8_BAR; PG8_MMA(1, 0, At, B0); PG8_MMA(1, 1, At, B1); PG8_BAR; PG8_SCHED;
            } else {
            PG8_LDB(B0, 0, 0); PG8_SCHED; PG8_LDA(At, 0, 0); PG8_STAGE(PG8_SA(1, 1), a1 + hstep, voffA);
            PG8_WAIT_L(8); PG8_BAR; PG8_WAIT_L(0); PG8_MMA(0, 0, At, B0); PG8_BAR; PG8_SCHED;
            PG8_LDB(B1, 0, 1); PG8_STAGE(PG8_SB(0, 0), b2, voffB);
            PG8_BAR; PG8_WAIT_L(0); PG8_MMA(0, 1, At, B1); PG8_BAR;
            PG8_LDA(At, 0, 1); PG8_STAGE(PG8_SA(0, 0), a2, voffA);
            PG8_BAR; PG8_WAIT_L(0); PG8_MMA(1, 0, At, B0); PG8_BAR; PG8_SCHED;
            PG8_STAGE(PG8_SB(0, 1), b2 + hstep, voffB);
            PG8_WAIT_V(6); PG8_BAR; PG8_MMA(1, 1, At, B1); PG8_BAR;
            PG8_LDB(B0, 1, 0); PG8_SCHED; PG8_LDA(At, 1, 0); PG8_STAGE(PG8_SA(0, 1), a2 + hstep, voffA);
            PG8_WAIT_L(8); PG8_BAR; PG8_WAIT_L(0); PG8_MMA(0, 0, At, B0); PG8_BAR; PG8_SCHED;
            PG8_LDB(B1, 1, 1); PG8_STAGE(PG8_SB(1, 0), b3, voffB);
            PG8_BAR; PG8_WAIT_L(0); PG8_MMA(0, 1, At, B1); PG8_BAR;
            PG8_LDA(At, 1, 1); PG8_STAGE(PG8_SA(1, 0), a3, voffA);
            PG8_BAR; PG8_WAIT_L(0); PG8_MMA(1, 0, At, B0); PG8_BAR; PG8_SCHED;
            PG8_STAGE(PG8_SB(1, 1), b3 + hstep, voffB);
            PG8_WAIT_V(6); PG8_BAR; PG8_MMA(1, 1, At, B1); PG8_BAR;
            }
        }
        if constexpr (ALIGN_EPI) { if (wr == 0) PG8_BAR; }
        if constexpr (!Epi::AFTER_DRAIN) { E(acc, cur, wr, wc, fr, fq); S.done(cur); }
        if (!has_next) break;
#pragma unroll
        for (int a = 0; a < 2; ++a)
#pragma unroll
            for (int b = 0; b < 2; ++b)
#pragma unroll
                for (int m = 0; m < 4; ++m)
#pragma unroll
                    for (int n = 0; n < 2; ++n) acc[a][b][m][n] = (f32x4){0.f, 0.f, 0.f, 0.f};
        cur = nxt; cA = nA; cB = nB; ++ui;
        if constexpr (ALIGN_EPI) { if (wr == 1) PG8_BAR; }
    }
    PG8_WAIT_V(0);
    if constexpr (!ALIGN_EPI) { if (wr == 0) PG8_BAR; }
    PG8_BAR;
    if constexpr (Epi::AFTER_DRAIN) { E.fused(acc, cur, wr, wc, fr, fq, lds, wid, lane); S.done(cur); }
#undef PG8_SA
#undef PG8_SB
#undef PG8_STAGE
#undef PG8_LDA
#undef PG8_LDB
#undef PG8_MMA
#undef PG8_WAIT_V
#undef PG8_WAIT_L
#undef PG8_BAR
#undef PG8_SCHED
}
}
namespace att {
#define ATT_LAS __attribute__((address_space(3)))
typedef unsigned short bf16_t;
typedef short bf16x8 __attribute__((ext_vector_type(8)));
typedef short s16x4 __attribute__((ext_vector_type(4)));
typedef float f32x16 __attribute__((ext_vector_type(16)));
typedef unsigned u32x4 __attribute__((ext_vector_type(4)));
constexpr size_t ZH = (size_t)32768 * 128;
#define KSWZ(row, colB) ((row) * 256 + ((colB) ^ (((row) & 7) << 4)))
#define SBAR() __builtin_amdgcn_sched_barrier(0)
__device__ __forceinline__ int crow(int r, int hi) { return (r & 3) + 8 * (r >> 2) + 4 * hi; }
__device__ __forceinline__ unsigned cvtpk(float lo, float hi) { unsigned r; asm volatile("v_cvt_pk_bf16_f32 %0, %1, %2" : "=v"(r) : "v"(lo), "v"(hi)); return r; }
__device__ __forceinline__ int v_st(int k, int c) { const int kk = (k & ~0xC) | ((k & 4) << 1) | ((k & 8) >> 1); return ((kk >> 3) * 4 + (c >> 5)) * 512 + ((kk & 7) * 32 + (c & 31)) * 2; }
__device__ __forceinline__ int v_rd_base(int lane) { return ((lane & 3) << 3) | (((lane >> 2) & 3) << 6) | (((lane >> 4) & 1) << 5) | (((lane >> 5) & 1) << 8); }
constexpr int v_rd_off(int d0, int ks, int half) { return d0 * 512 + ks * 4096 + half * 2048; }
template <int OFF> __device__ __forceinline__ s16x4 tr_read(unsigned vb) { s16x4 r; asm volatile("ds_read_b64_tr_b16 %0, %1 offset:%2" : "=&v"(r) : "v"(vb), "i"(OFF) : "memory"); return r; }
template <int D0> __device__ __forceinline__ void pv_one(f32x16& od, unsigned vb, bf16x8 pa0, bf16x8 pa1, bf16x8 pa2, bf16x8 pa3) {
  const s16x4 l0 = tr_read<v_rd_off(D0, 0, 0)>(vb), h0 = tr_read<v_rd_off(D0, 0, 1)>(vb), l1 = tr_read<v_rd_off(D0, 1, 0)>(vb), h1 = tr_read<v_rd_off(D0, 1, 1)>(vb);
  const s16x4 l2 = tr_read<v_rd_off(D0, 2, 0)>(vb), h2 = tr_read<v_rd_off(D0, 2, 1)>(vb), l3 = tr_read<v_rd_off(D0, 3, 0)>(vb), h3 = tr_read<v_rd_off(D0, 3, 1)>(vb);
  asm volatile("s_waitcnt lgkmcnt(0)" ::: "memory"); SBAR();
#define PK(L, H) (bf16x8){L[0], L[1], L[2], L[3], H[0], H[1], H[2], H[3]}
  od = __builtin_amdgcn_mfma_f32_32x32x16_bf16(pa0, PK(l0, h0), od, 0, 0, 0);
  od = __builtin_amdgcn_mfma_f32_32x32x16_bf16(pa1, PK(l1, h1), od, 0, 0, 0);
  od = __builtin_amdgcn_mfma_f32_32x32x16_bf16(pa2, PK(l2, h2), od, 0, 0, 0);
  od = __builtin_amdgcn_mfma_f32_32x32x16_bf16(pa3, PK(l3, h3), od, 0, 0, 0);
#undef PK
}
template <int D0> __device__ __forceinline__ void rd8(unsigned vb, s16x4 (&r)[8]) {
  r[0] = tr_read<v_rd_off(D0, 0, 0)>(vb); r[1] = tr_read<v_rd_off(D0, 0, 1)>(vb); r[2] = tr_read<v_rd_off(D0, 1, 0)>(vb); r[3] = tr_read<v_rd_off(D0, 1, 1)>(vb);
  r[4] = tr_read<v_rd_off(D0, 2, 0)>(vb); r[5] = tr_read<v_rd_off(D0, 2, 1)>(vb); r[6] = tr_read<v_rd_off(D0, 3, 0)>(vb); r[7] = tr_read<v_rd_off(D0, 3, 1)>(vb);
}
__device__ __forceinline__ void mm4(f32x16& od, bf16x8 pa0, bf16x8 pa1, bf16x8 pa2, bf16x8 pa3, const s16x4 (&r)[8]) {
#define PK(L, H) (bf16x8){L[0], L[1], L[2], L[3], H[0], H[1], H[2], H[3]}
  od = __builtin_amdgcn_mfma_f32_32x32x16_bf16(pa0, PK(r[0], r[1]), od, 0, 0, 0);
  od = __builtin_amdgcn_mfma_f32_32x32x16_bf16(pa1, PK(r[2], r[3]), od, 0, 0, 0);
  od = __builtin_amdgcn_mfma_f32_32x32x16_bf16(pa2, PK(r[4], r[5]), od, 0, 0, 0);
  od = __builtin_amdgcn_mfma_f32_32x32x16_bf16(pa3, PK(r[6], r[7]), od, 0, 0, 0);
#undef PK
}
__device__ __forceinline__ void pv_all(f32x16 (&o)[4], unsigned vb, bf16x8 pa0, bf16x8 pa1, bf16x8 pa2, bf16x8 pa3) {
  s16x4 A[8], B[8];
  rd8<0>(vb, A); rd8<1>(vb, B);
  asm volatile("s_waitcnt lgkmcnt(8)" ::: "memory"); SBAR();
  mm4(o[0], pa0, pa1, pa2, pa3, A); SBAR();
  rd8<2>(vb, A);
  asm volatile("s_waitcnt lgkmcnt(8)" ::: "memory"); SBAR();
  mm4(o[1], pa0, pa1, pa2, pa3, B); SBAR();
  rd8<3>(vb, B);
  asm volatile("s_waitcnt lgkmcnt(8)" ::: "memory"); SBAR();
  mm4(o[2], pa0, pa1, pa2, pa3, A); SBAR();
  asm volatile("s_waitcnt lgkmcnt(0)" ::: "memory"); SBAR();
  mm4(o[3], pa0, pa1, pa2, pa3, B);
}
__device__ __forceinline__ void qkt(f32x16& p0, f32x16& p1, const ATT_LAS unsigned char* Ks, const bf16x8* qr, int r32, int hi) {
  p0 = f32x16{}; p1 = f32x16{};
#pragma unroll
  for (int d0 = 0; d0 < 8; ++d0) { const int cb = (d0 * 16 + hi * 8) * 2;
    const bf16x8 b0 = *(const ATT_LAS bf16x8*)(Ks + KSWZ(r32, cb));
    const bf16x8 b1 = *(const ATT_LAS bf16x8*)(Ks + KSWZ(32 + r32, cb));
    p0 = __builtin_amdgcn_mfma_f32_32x32x16_bf16(b0, qr[d0], p0, 0, 0, 0);
    p1 = __builtin_amdgcn_mfma_f32_32x32x16_bf16(b1, qr[d0], p1, 0, 0, 0); }
}
struct Desc { int tbase, dil, Lf, q0, qcol0, kcol0, g; float m0, m1; };
template <int NS> __device__ __forceinline__ Desc decode(int it, int L, int lgq, const float* sink) {
  Desc d; const int nqb = 1 << lgq;
  if constexpr (NS == 1) {
    const int pr = it & 1, kvh = (it >> 1) & 1, qbs = it >> 2, s = qbs >> lgq, qb = qbs & (nqb - 1), h0 = kvh * 4 + pr * 2;
    d.tbase = s * L; d.dil = 1; d.Lf = L; d.q0 = qb * 128; d.qcol0 = h0 * 128; d.kcol0 = 1024 + kvh * 128; d.g = 0;
    d.m0 = sink[h0] * 1.4426950408889634f; d.m1 = sink[h0 + 1] * 1.4426950408889634f;
  } else {
    const int g = it >> 9, jj = it & 511, pr = jj & 1, rest = jj >> 1;
    const int lgd = 2 * g, lgn = lgq - lgd;
    const int s = rest >> lgq, rr = rest & (nqb - 1), res = rr >> lgn, qb = rr & ((1 << lgn) - 1), cb = 1536 + g * 1536 + pr * 256;
    d.tbase = s * L + res; d.dil = 1 << lgd; d.Lf = L >> lgd; d.q0 = qb * 128; d.qcol0 = cb; d.kcol0 = cb + 512; d.g = g;
    d.m0 = -1e30f; d.m1 = -1e30f;
  }
  return d;
}
template <int NS>
__device__ __forceinline__ void attn_items(ATT_LAS unsigned char* lds, const bf16_t* __restrict__ Z, int first, int limit, int stride, int L, const float* sink,
                                           bf16_t* __restrict__ Obase, size_t ogstride, int opitch, float* __restrict__ lsebase, size_t lgstride) {
  if (first >= limit) return;
  constexpr int HW = (NS == 1) ? 128 : 64, NT = (128 + 2 * HW) / 64;
  constexpr float L_INIT = (NS == 1) ? 1.0f : 0.0f; constexpr int VD = (NS == 1) ? 256 : 512;
  int tid_ = threadIdx.x; asm volatile("" : "+v"(tid_));
  const int tid = tid_, wid = __builtin_amdgcn_readfirstlane(tid >> 6), lane = tid & 63, r32 = lane & 31, hi = lane >> 5;
  const int qi = wid & 3, grp = wid >> 2, strm = (NS == 2) ? grp : 0;
  const ATT_LAS unsigned char* Kl = lds + strm * 32768;
  ATT_LAS float* li_l = (ATT_LAS float*)(lds + 131072 + 512) + wid * 64; ATT_LAS float* al_l = li_l + 32;
  const int sr = tid >> 4, sc = (tid & 15) * 8;
  const int vst0 = v_st(sr, sc), vst1 = v_st(32 + sr, sc), kst0 = KSWZ(sr, sc * 2), kst1 = KSWZ(32 + sr, sc * 2);
  const unsigned vb0 = (unsigned)(size_t)(lds + strm * 32768 + 16384) + (unsigned)v_rd_base(lane);
  constexpr int BUFSZ = NS * 32768;
  bf16x8 qr[8]; bf16x8 stg[NS][4];
#define ALOAD(D_, t) do { int k0_ = (D_).q0 - HW + (t) * 64 + sr, k1_ = k0_ + 32; k0_ = k0_ < 0 ? 0 : (k0_ > (D_).Lf - 1 ? (D_).Lf - 1 : k0_); k1_ = k1_ < 0 ? 0 : (k1_ > (D_).Lf - 1 ? (D_).Lf - 1 : k1_); \
    const bf16_t* p0_ = Z + (size_t)((D_).kcol0 >> 7) * ZH + (size_t)((D_).tbase + k0_ * (D_).dil) * 128 + sc; const bf16_t* p1_ = Z + (size_t)((D_).kcol0 >> 7) * ZH + (size_t)((D_).tbase + k1_ * (D_).dil) * 128 + sc; \
    _Pragma("unroll") for (int s_ = 0; s_ < NS; ++s_) { stg[s_][0] = *(const bf16x8*)(p0_ + s_ * ZH); stg[s_][1] = *(const bf16x8*)(p1_ + s_ * ZH); \
      stg[s_][2] = *(const bf16x8*)(p0_ + (VD / 128 + s_) * ZH); stg[s_][3] = *(const bf16x8*)(p1_ + (VD / 128 + s_) * ZH); } } while (0)
#define AWRITE(b) do { _Pragma("unroll") for (int s = 0; s < NS; ++s) { ATT_LAS unsigned char* bb_ = lds + (b) * BUFSZ + s * 32768; \
      *(ATT_LAS bf16x8*)(bb_ + kst0) = stg[s][0]; *(ATT_LAS bf16x8*)(bb_ + kst1) = stg[s][1]; \
      *(ATT_LAS bf16x8*)(bb_ + 16384 + vst0) = stg[s][2]; *(ATT_LAS bf16x8*)(bb_ + 16384 + vst1) = stg[s][3]; } } while (0)
#define QLOAD(D_) do { const bf16_t* Qw_ = Z + (size_t)(((D_).qcol0 >> 7) + grp) * ZH + (size_t)((D_).tbase + ((D_).q0 + 32 * qi + r32) * (D_).dil) * 128 + hi * 8; \
    _Pragma("unroll") for (int d0 = 0; d0 < 8; ++d0) qr[d0] = *(const bf16x8*)(Qw_ + d0 * 16); } while (0)
  const int lgq = (L == 2048) ? 4 : 5;
  Desc cur = decode<NS>(first, L, lgq, sink);
  QLOAD(cur); ALOAD(cur, 0);
  for (int it = first; it < limit; it += stride) {
    const int itn = it + stride < limit ? it + stride : it;
    const int tbase = cur.tbase, dil = cur.dil, Lf = cur.Lf, q0 = cur.q0;
    const int kstart = q0 - HW, qa = q0 + 32 * qi;
    float m_reg = grp ? cur.m1 : cur.m0, l_reg = L_INIT;
    bool ozero = true;
    f32x16 o[4];
#pragma unroll
    for (int d = 0; d < 4; ++d) o[d] = f32x16{};
    __syncthreads();
    AWRITE(0); __syncthreads();
    const int wlo = qa - HW > 0 ? qa - HW : 0, whi = qa + 31 + HW < Lf - 1 ? qa + 31 + HW : Lf - 1;
    const int qpos = qa + r32;
    const int vlo = (qpos - HW > 0 ? qpos - HW : 0), vhi = (qpos + HW < Lf - 1 ? qpos + HW : Lf - 1);
#pragma unroll 1
    for (int t = 0; t < NT; ++t) {
      const int b = t & 1; const bool last = (t == NT - 1);
      if (!last) ALOAD(cur, t + 1); else { const Desc nx = decode<NS>(itn, L, lgq, sink); ALOAD(nx, 0); }
      const int tlo = kstart + 64 * t, thi = tlo + 63;
      if (tlo <= whi && thi >= wlo) {
        f32x16 p0, p1;
        qkt(p0, p1, Kl + b * BUFSZ, qr, r32, hi);
        const bool interior = (tlo >= qa + 31 - HW) && (thi <= qa + HW) && (tlo >= 0) && (thi < Lf);
        if (!interior) {
          const int lo = vlo - tlo - 4 * hi, up = vhi - tlo - 4 * hi;
#pragma unroll
          for (int r = 0; r < 16; ++r) { const int c = (r & 3) + 8 * (r >> 2);
            p0[r] = (c >= lo && c <= up) ? p0[r] : -INFINITY; p1[r] = (c + 32 >= lo && c + 32 <= up) ? p1[r] : -INFINITY; }
        }
        float pmax = p0[0];
#pragma unroll
        for (int r = 1; r < 16; ++r) pmax = fmaxf(pmax, p0[r]);
#pragma unroll
        for (int r = 0; r < 16; ++r) pmax = fmaxf(pmax, p1[r]);
        { auto rr = __builtin_amdgcn_permlane32_swap(__float_as_uint(pmax), __float_as_uint(pmax), false, false);
          pmax = fmaxf(__uint_as_float(rr[0]), __uint_as_float(rr[1])); }
        float mn = m_reg, alpha = 1.f;
        const bool grow = !__all(pmax - m_reg <= 8.0f);
        if (grow) { mn = fmaxf(m_reg, pmax); alpha = __builtin_amdgcn_exp2f(m_reg - mn); m_reg = mn; }
        float ps = 0.f;
#pragma unroll
        for (int r = 0; r < 16; ++r) { p0[r] = __builtin_amdgcn_exp2f(p0[r] - mn); p1[r] = __builtin_amdgcn_exp2f(p1[r] - mn); ps += p0[r] + p1[r]; }
        { auto rr = __builtin_amdgcn_permlane32_swap(__float_as_uint(ps), __float_as_uint(ps), false, false);
          ps = __uint_as_float(rr[0]) + __uint_as_float(rr[1]); }
        l_reg = l_reg * alpha + ps;
        bf16x8 pa0, pa1, pa2, pa3;
#define PK4(P, BASE, OUT) do { unsigned a0 = cvtpk(P[BASE + 0], P[BASE + 1]), a1 = cvtpk(P[BASE + 2], P[BASE + 3]);   \
    unsigned b0 = cvtpk(P[BASE + 4], P[BASE + 5]), b1 = cvtpk(P[BASE + 6], P[BASE + 7]);                              \
    auto r0 = __builtin_amdgcn_permlane32_swap(a0, b0, false, false); auto r1 = __builtin_amdgcn_permlane32_swap(a1, b1, false, false); \
    u32x4 w = {r0[0], r1[0], r0[1], r1[1]}; OUT = __builtin_bit_cast(bf16x8, w); } while (0)
        PK4(p0, 0, pa0); PK4(p0, 8, pa1); PK4(p1, 0, pa2); PK4(p1, 8, pa3);
#undef PK4
        if (grow && !ozero && __any(alpha < 1.f)) { if (hi == 0) al_l[r32] = alpha; asm volatile("s_waitcnt lgkmcnt(0)" ::: "memory");
#pragma unroll
          for (int r = 0; r < 16; ++r) { const float a = al_l[crow(r, hi)];
#pragma unroll
            for (int d = 0; d < 4; ++d) o[d][r] *= a; } }
        const unsigned vb = vb0 + b * BUFSZ;
        pv_all(o, vb, pa0, pa1, pa2, pa3);
        ozero = false;
      }
      if (!last) { AWRITE(b ^ 1); __syncthreads(); }
    }
    const Desc nxt = decode<NS>(itn, L, lgq, sink);
    QLOAD(nxt);
    if (hi == 0) li_l[r32] = l_reg; asm volatile("s_waitcnt lgkmcnt(0)" ::: "memory");
    const int ocol0 = (NS == 1) ? cur.qcol0 : cur.qcol0 - 1536 - cur.g * 1536;
    bf16_t* Ow = Obase + (size_t)cur.g * ogstride + ocol0 + grp * 128 + r32;
#pragma unroll
    for (int r = 0; r < 16; ++r) { const int orow = crow(r, hi); const float rl = __builtin_amdgcn_rcpf(li_l[orow]);
      bf16_t* op = Ow + (size_t)(tbase + (qa + orow) * dil) * opitch;
#pragma unroll
      for (int d0 = 0; d0 < 4; ++d0) op[d0 * 32] = (bf16_t)(cvtpk(o[d0][r] * rl, 0.f) & 0xffffu); }
    if (NS == 2 && hi == 0) lsebase[(size_t)cur.g * lgstride + (size_t)(tbase + (qa + r32) * dil) * 4 + (ocol0 >> 7) + grp] = m_reg + __builtin_amdgcn_logf(l_reg);
    cur = nxt;
  }
#undef ALOAD
#undef AWRITE
#undef QLOAD
}
}
#define GAS __attribute__((address_space(1)))
#define LAS __attribute__((address_space(3)))
typedef unsigned short bf16;
typedef unsigned v4u __attribute__((ext_vector_type(4)));
typedef unsigned v2u __attribute__((ext_vector_type(2)));
typedef float f32x4 __attribute__((ext_vector_type(4)));
constexpr int NWAVES = 8, RB = 4;
constexpr int D = 1024, DIN = 8192, DFF = 4096, TOK = 98304, CH = 32768, NCHUNK = 3;
static_assert(pg8::ZH == (size_t)CH * 128 && att::ZH == pg8::ZH, "Z head-major block size");
constexpr float EPS = 1e-6f;
constexpr size_t MiB = 1u << 20;
constexpr size_t WS_WIN = 1 * MiB, WS_WA = 17 * MiB, WS_WB = 19 * MiB, WS_WO = 20 * MiB, WS_W1 = 22 * MiB, WS_W2 = 30 * MiB, WS_RC = 38 * MiB, WS_RS = 39 * MiB;
constexpr size_t WS_XN = 40 * MiB, WS_Z = 104 * MiB, WS_U = WS_Z, WS_OAB = 616 * MiB, WS_F = WS_OAB, WS_OB3 = 712 * MiB, WS_MIX = WS_OB3, WS_LSE = 808 * MiB, WS_G = 810 * MiB, WS_X1B = WS_G, WS_RS1 = 809 * MiB + 512 * 1024, WS_END = 874 * MiB;
constexpr int RING_BYTES = 131072, LDS_BYTES = 147456;

__device__ __forceinline__ unsigned f2bf(float f) { unsigned u = __builtin_bit_cast(unsigned, f); return (u + 0x7fffu + ((u >> 16) & 1u)) >> 16; }
__device__ __forceinline__ unsigned pk2(float lo, float hi) { return f2bf(lo) | (f2bf(hi) << 16); }
__device__ __forceinline__ float wave_sum(float v) {
#pragma unroll
    for (int o = 1; o < 64; o <<= 1) v += __shfl_xor(v, o);
    return v;
}
__device__ __forceinline__ int win_dest(int n) {
    const int hh = n >> 7; const bool rope = (hh < 10) || (hh >= 12 && hh < 48 && ((hh - 12) % 12) < 8);
    if (!rope) return n;
    const int c = n & 127, half = c >> 6, j = c & 63;
    return (n & ~127) + 32 * (j >> 4) + 8 * ((j >> 2) & 3) + 4 * half + (j & 3);
}
__device__ __forceinline__ void p0_transpose_item(const float* W, int K, int N, bf16* WT, int pitch, int koff, bool perm, LAS float* scr, int item, int lane) {
    const int nblk = N / 32, kb = item / nblk, nb = item % nblk, k0 = 64 * kb, n0 = 32 * nb;
    float t_[32];
#pragma unroll
    for (int i = 0; i < 32; ++i) { const int kk = 2 * i + (lane >> 5); t_[i] = W[(size_t)(k0 + kk) * N + n0 + (lane & 31)]; }
#pragma unroll
    for (int i = 0; i < 32; ++i) { const int kk = 2 * i + (lane >> 5); scr[kk * 33 + (lane & 31)] = t_[i]; }
    asm volatile("s_waitcnt lgkmcnt(0)" ::: "memory");
    const int c = lane & 7;
#pragma unroll
    for (int j = 0; j < 4; ++j) { const int n = (lane >> 3) + 8 * j; const LAS float* s = scr + (8 * c) * 33 + n;
        v4u o; o.x = pk2(s[0 * 33], s[1 * 33]); o.y = pk2(s[2 * 33], s[3 * 33]); o.z = pk2(s[4 * 33], s[5 * 33]); o.w = pk2(s[6 * 33], s[7 * 33]);
        const int dst = perm ? win_dest(n0 + n) : (n0 + n);
        *(v4u*)(WT + (size_t)dst * pitch + koff + k0 + 8 * c) = o; }
    asm volatile("s_waitcnt lgkmcnt(0)" ::: "memory");
}
#define RLX_AGENT __ATOMIC_RELAXED, __HIP_MEMORY_SCOPE_AGENT
#define XB_TMO      128
#define XB_XCNT(j)  (256  + 64 * (j))
#define XB_XSUB(j)  (1280 + 64 * (j))
#define XB_XGEN(j)  (2304 + 64 * (j))
#define XB_TOP      3328
#define XB_TOPGEN   3392
#define XCD_BAR_WORDS 3456
#define XB_SPIN_CAP (1u << 18)

__device__ __forceinline__ unsigned xb_ld(unsigned* p)              { return __hip_atomic_load(p, __ATOMIC_RELAXED, __HIP_MEMORY_SCOPE_AGENT); }
__device__ __forceinline__ unsigned xb_add(unsigned* p, unsigned v) { return __hip_atomic_fetch_add(p, v, __ATOMIC_RELAXED, __HIP_MEMORY_SCOPE_AGENT); }
__device__ __forceinline__ unsigned xb_xcc_id() { return (unsigned)__builtin_amdgcn_s_getreg((3 << 11) | 20) & 0xFu; }
#define XB_SPIN(cond, bar) do { unsigned _sp = 0; while (cond) { __builtin_amdgcn_s_sleep(1); \
    if ((++_sp & 255u) == 0u) { if (xb_ld(&(bar)[XB_TMO])) break; if (_sp > XB_SPIN_CAP) { atomicAdd(&(bar)[XB_TMO], 1u); break; } } } } while (0)

struct XcdBarrier {
    unsigned* bar; unsigned x;
    volatile LAS unsigned* st;
};

__device__ __forceinline__ XcdBarrier xcd_barrier_post(unsigned* bar, volatile LAS unsigned* st) {
    XcdBarrier b; b.bar = bar; b.x = xb_xcc_id(); b.st = st;
    if (threadIdx.x == 0) (void)xb_add(&bar[XB_XCNT(b.x)], 1u);
    return b;
}
__device__ __forceinline__ void xcd_barrier_complete(unsigned* bar, unsigned x, unsigned& nloc, unsigned& nx) {
    const unsigned G = gridDim.x * gridDim.y * gridDim.z;
    unsigned sum, cnt, mine, sp = 0u;
    for (;;) {
        sum = 0u; cnt = 0u; mine = 0u;
#pragma unroll
        for (unsigned j = 0; j < 16; ++j) { const unsigned c = xb_ld(&bar[XB_XCNT(j)]); sum += c; cnt += (c > 0u) ? 1u : 0u; mine = (j == x) ? c : mine; }
        if (sum == G) break;
        __builtin_amdgcn_s_sleep(1);
        if ((++sp & 255u) == 0u) { if (xb_ld(&bar[XB_TMO])) break; if (sp > XB_SPIN_CAP) { atomicAdd(&bar[XB_TMO], 1u); break; } }
    }
    nloc = mine > 0u ? mine : 1u; nx = cnt > 0u ? cnt : 1u;
}

__device__ __forceinline__ void xcd_barrier(const XcdBarrier& b) {
    asm volatile("s_waitcnt vmcnt(0)" ::: "memory");
    __syncthreads();
    if (threadIdx.x == 0) {
        unsigned* bar = b.bar;
        __builtin_amdgcn_s_waitcnt(0);
        unsigned nloc = b.st[0], nx = b.st[1];
        if (nloc == 0u) { xcd_barrier_complete(bar, b.x, nloc, nx); b.st[0] = nloc; b.st[1] = nx; }
        const unsigned old = xb_add(&bar[XB_XSUB(b.x)], 1u);
        const unsigned gen = old / nloc;
        if (old + 1u == (gen + 1u) * nloc) {
            __builtin_amdgcn_fence(__ATOMIC_RELEASE, "agent");
            asm volatile("s_waitcnt vmcnt(0)" ::: "memory");
            const unsigned og = xb_add(&bar[XB_TOP], 1u);
            const unsigned tg = og / nx;
            if (og + 1u == (tg + 1u) * nx) xb_add(&bar[XB_TOPGEN], 1u);
            else XB_SPIN(xb_ld(&bar[XB_TOPGEN]) == tg, bar);
            __builtin_amdgcn_fence(__ATOMIC_ACQUIRE, "agent");
            xb_add(&bar[XB_XGEN(b.x)], 1u);
            asm volatile("s_waitcnt vmcnt(0)" ::: "memory");
        } else {
            XB_SPIN(xb_ld(&bar[XB_XGEN(b.x)]) == gen, bar);
            __builtin_amdgcn_fence(__ATOMIC_ACQUIRE, "agent");
            asm volatile("s_waitcnt vmcnt(0)" ::: "memory");
        }
    }
    __syncthreads();
}

struct Args { const float* in[13]; float* out; unsigned char* ws; int cg_seams; int pad; };

__device__ __forceinline__ void load_row_bf16(const bf16* row, int lane, f32x4 (&v)[4]) {
#pragma unroll
    for (int j = 0; j < 4; ++j) { const v2u w = __builtin_nontemporal_load((const v2u*)(row + 4 * lane + 256 * j));
        v[j] = (f32x4){__builtin_bit_cast(float, w.x << 16), __builtin_bit_cast(float, w.x & 0xffff0000u), __builtin_bit_cast(float, w.y << 16), __builtin_bit_cast(float, w.y & 0xffff0000u)}; }
}
__device__ __forceinline__ void store_row_bf16(bf16* row, int lane, const f32x4 (&v)[4]) {
#pragma unroll
    for (int j = 0; j < 4; ++j) { v2u w; w.x = pk2(v[j][0], v[j][1]); w.y = pk2(v[j][2], v[j][3]); *(v2u*)(row + 4 * lane + 256 * j) = w; }
}
__device__ __forceinline__ float sumsq4(const f32x4 (&v)[4]) {
    float s = 0.f;
#pragma unroll
    for (int j = 0; j < 4; ++j) s += (v[j][0] * v[j][0] + v[j][1] * v[j][1]) + (v[j][2] * v[j][2] + v[j][3] * v[j][3]);
    return wave_sum(s);
}

#define KARG(i) (((const float* const volatile __attribute__((address_space(4)))*)__builtin_amdgcn_kernarg_segment_ptr())[i])
#define WSB() ((unsigned char*)KARG(14))
__global__ void __launch_bounds__(NWAVES * 64, 2) fwd_mega(Args args) {
    extern __shared__ __attribute__((aligned(16))) unsigned char lds_raw[];
    cg::grid_group grid = cg::this_grid();
    LAS unsigned char* lds = (LAS unsigned char*)lds_raw;
    const int tid = threadIdx.x, wave = __builtin_amdgcn_readfirstlane(tid >> 6);
#define FRESH_LANE() int lane = threadIdx.x & 63; asm volatile("" : "+v"(lane)); int gwl = gw; asm volatile("" : "+s"(gwl))
    const int G = gridDim.x, gw = blockIdx.x * NWAVES + wave, NGW = G * NWAVES;
    if (tid < 64) ((LAS unsigned*)(lds + RING_BYTES))[tid] = 0u;
    __syncthreads();
    const XcdBarrier bar = xcd_barrier_post((unsigned*)KARG(14), (volatile LAS unsigned*)(lds + RING_BYTES + 32));
    const int cg_seams = ((const volatile int __attribute__((address_space(4)))*)__builtin_amdgcn_kernarg_segment_ptr())[30];
#define GRID_BAR() do { if (cg_seams) grid.sync(); else xcd_barrier(bar); } while (0)
    {
        FRESH_LANE();
        unsigned char* ws = WSB();
        const float* w_in = KARG(2); const float* w_a = KARG(4); const float* w_b = KARG(5); const float* w_o = KARG(6); const float* w_1 = KARG(11); const float* w_2 = KARG(12);
        bf16* Win_t = (bf16*)(ws + WS_WIN); bf16* Wa_t = (bf16*)(ws + WS_WA); bf16* Wo_t = (bf16*)(ws + WS_WO); bf16* W1_t = (bf16*)(ws + WS_W1); bf16* W2_t = (bf16*)(ws + WS_W2);
        float* ropeC = (float*)(ws + WS_RC); float* ropeS = (float*)(ws + WS_RS);
        LAS float* scr = (LAS float*)(lds + wave * 16384);
        constexpr int I_IN = (D / 64) * (DIN / 32), I_A = (D / 64) * (D / 32), I_B = (512 / 64) * (D / 32), I_O = I_A, I_1 = (D / 64) * (DFF / 32), I_2 = (DFF / 64) * (D / 32);
        constexpr int NITEMS = I_IN + I_A + I_B + I_O + I_1 + I_2;
        for (int it = gwl; it < NITEMS; it += NGW) {
            int r = it;
            if (r < I_IN) { p0_transpose_item(w_in, D, DIN, Win_t, D, 0, true, scr, r, lane); continue; } r -= I_IN;
            if (r < I_A) { p0_transpose_item(w_a, D, D, Wa_t, 1536, 0, false, scr, r, lane); continue; } r -= I_A;
            if (r < I_B) { p0_transpose_item(w_b, 512, D, Wa_t, 1536, 1024, false, scr, r, lane); continue; } r -= I_B;
            if (r < I_O) { p0_transpose_item(w_o, D, D, Wo_t, D, 0, false, scr, r, lane); continue; } r -= I_O;
            if (r < I_1) { p0_transpose_item(w_1, D, DFF, W1_t, D, 0, false, scr, r, lane); continue; } r -= I_1;
            p0_transpose_item(w_2, DFF, D, W2_t, DFF, 0, false, scr, r, lane);
        }
    }
    for (int ck = 0; ck < NCHUNK; ++ck) {
        const int L = (ck < 2) ? 2048 : 4096;
#define XIN() ((ck < 2) ? KARG(0) + (size_t)ck * CH * D : KARG(1))
#define XOUT() ((float*)KARG(13) + (size_t)ck * CH * D)
#define WP(T, off) ((T*)(WSB() + (off)))
        { FRESH_LANE(); const float* xin = XIN(); const float* g1 = KARG(7); bf16* XN = WP(bf16, WS_XN); float* RS1 = WP(float, WS_RS1);
        f32x4 gv[4];
#pragma unroll
        for (int j = 0; j < 4; ++j) gv[j] = *(const f32x4*)(g1 + 4 * lane + 256 * j);
        for (int m = gwl * RB; m < CH; m += NGW * RB) {
            f32x4 v[RB][4];
#pragma unroll
            for (int k = 0; k < RB; ++k)
#pragma unroll
                for (int j = 0; j < 4; ++j) v[k][j] = __builtin_nontemporal_load((const f32x4*)(xin + (size_t)(m + k) * D + 4 * lane + 256 * j));
#pragma unroll
            for (int k = 0; k < RB; ++k) {
                const float rs = 1.0f / sqrtf(sumsq4(v[k]) * (1.0f / D) + EPS);
#pragma unroll
                for (int j = 0; j < 4; ++j) v[k][j] = v[k][j] * rs * gv[j];
                store_row_bf16(XN + (size_t)(m + k) * D, lane, v[k]);
                if (lane == 0) RS1[m + k] = rs;
            }
        }
        }
        GRID_BAR();
        { bf16* XN = WP(bf16, WS_XN); bf16* Win_t = WP(bf16, WS_WIN); bf16* Z = WP(bf16, WS_Z); float* ropeC = WP(float, WS_RC); float* ropeS = WP(float, WS_RS);
          pg8::Gemm g{XN, Win_t, CH, DIN, D}; pg8::StaticOrder S; S.init(CH, DIN, G, (int)blockIdx.x); S.wgm = 4;
          pg8::Epi<0> E{Z, DIN, nullptr, ropeC, ropeS, L - 1, 0.088388347648318440f * 1.4426950408889634f};
          pg8::gemm_phase<pg8::Epi<0>, pg8::StaticOrder, true, true>(lds, g, S, E); }
        GRID_BAR();
        {
            const float* sink = KARG(3); bf16* Z = WP(bf16, WS_Z); bf16* OA = WP(bf16, WS_OAB); bf16* OB3 = WP(bf16, WS_OB3); float* LSE = WP(float, WS_LSE);
            const int vcu = (G % 8 == 0) ? ((int)blockIdx.x % 8) * (G / 8) + (int)blockIdx.x / 8 : (int)blockIdx.x;
            att::attn_items<1>(lds, Z, vcu, 1024, G, L, sink, OA, 0, 1536, nullptr, 0);
            att::attn_items<2>(lds, Z, vcu, 1536, G, L, sink, OB3, (size_t)CH * 512, 512, LSE, (size_t)CH * 4);
        }
        GRID_BAR();
        { FRESH_LANE(); bf16* OB3 = WP(bf16, WS_OB3); float* LSE = WP(float, WS_LSE); bf16* OBM = WP(bf16, WS_OAB) + 1024;
        const int hd = lane >> 4;
        for (int m0 = gwl * RB; m0 < CH; m0 += NGW * RB) {
            v4u a[RB], b[RB], c[RB]; float l0[RB], l1[RB], l2[RB];
#pragma unroll
            for (int k = 0; k < RB; ++k) { const size_t m = m0 + k;
                l0[k] = LSE[m * 4 + hd]; l1[k] = LSE[(size_t)CH * 4 + m * 4 + hd]; l2[k] = LSE[(size_t)2 * CH * 4 + m * 4 + hd];
                a[k] = __builtin_nontemporal_load((const v4u*)(OB3 + m * 512 + 8 * lane)); b[k] = __builtin_nontemporal_load((const v4u*)(OB3 + (size_t)CH * 512 + m * 512 + 8 * lane)); c[k] = __builtin_nontemporal_load((const v4u*)(OB3 + (size_t)2 * CH * 512 + m * 512 + 8 * lane)); }
#pragma unroll
            for (int k = 0; k < RB; ++k) {
                const float mx = fmaxf(l0[k], fmaxf(l1[k], l2[k]));
                float e0 = __builtin_amdgcn_exp2f(l0[k] - mx), e1 = __builtin_amdgcn_exp2f(l1[k] - mx), e2 = __builtin_amdgcn_exp2f(l2[k] - mx);
                const float inv = 1.0f / (e0 + e1 + e2); e0 *= inv; e1 *= inv; e2 *= inv;
                v4u o;
#define MRG(x) pk2(e0 * pg8::bf_lo(a[k].x) + e1 * pg8::bf_lo(b[k].x) + e2 * pg8::bf_lo(c[k].x), e0 * pg8::bf_hi(a[k].x) + e1 * pg8::bf_hi(b[k].x) + e2 * pg8::bf_hi(c[k].x))
                o.x = MRG(x); o.y = MRG(y); o.z = MRG(z); o.w = MRG(w);
#undef MRG
                *(v4u*)(OBM + (size_t)(m0 + k) * 1536 + 8 * lane) = o;
            }
        }
        }
        GRID_BAR();
        { bf16* OAB = WP(bf16, WS_OAB); bf16* Wab_t = WP(bf16, WS_WA); bf16* Gb = WP(bf16, WS_G); bf16* Z = WP(bf16, WS_Z);
          pg8::Gemm g{OAB, Wab_t, CH, D, 1536}; pg8::StaticOrder S; S.init(CH, D, G, (int)blockIdx.x);
          pg8::Epi<1> E{Gb, D, Z + 56 * pg8::ZH, nullptr, nullptr, 0, 1.f};
          pg8::gemm_phase<pg8::Epi<1>, pg8::StaticOrder, true, true>(lds, g, S, E); }
        GRID_BAR();
        { bf16* Gb = WP(bf16, WS_G); bf16* Wo_t = WP(bf16, WS_WO); bf16* MIX = WP(bf16, WS_MIX);
          pg8::Gemm g{Gb, Wo_t, CH, D, D}; pg8::StaticOrder S; S.init(CH, D, G, (int)blockIdx.x);
          pg8::Epi<3> E{MIX, D, nullptr, nullptr, nullptr, 0, 1.f};
          pg8::gemm_phase<pg8::Epi<3>, pg8::StaticOrder, true, true>(lds, g, S, E); }
        GRID_BAR();
        { FRESH_LANE(); const float* g1 = KARG(7); const float* g2 = KARG(8); const float* g3 = KARG(9); bf16* MIX = WP(bf16, WS_MIX); bf16* XN = WP(bf16, WS_XN); bf16* X1B = WP(bf16, WS_X1B); const float* RS1 = WP(float, WS_RS1);
        f32x4 gi1[4], gv2[4], gv3[4];
#pragma unroll
        for (int j = 0; j < 4; ++j) { const f32x4 t = *(const f32x4*)(g1 + 4 * lane + 256 * j); gi1[j] = (f32x4){1.0f / t[0], 1.0f / t[1], 1.0f / t[2], 1.0f / t[3]};
            gv2[j] = *(const f32x4*)(g2 + 4 * lane + 256 * j); gv3[j] = *(const f32x4*)(g3 + 4 * lane + 256 * j); }
        for (int m = gwl * RB; m < CH; m += NGW * RB) {
            f32x4 v[RB][4], x[RB][4]; float ir[RB];
#pragma unroll
            for (int k = 0; k < RB; ++k) { load_row_bf16(MIX + (size_t)(m + k) * D, lane, v[k]); load_row_bf16(XN + (size_t)(m + k) * D, lane, x[k]); ir[k] = 1.0f / RS1[m + k]; }
#pragma unroll
            for (int k = 0; k < RB; ++k) {
                const float rs = 1.0f / sqrtf(sumsq4(v[k]) * (1.0f / D) + EPS);
#pragma unroll
                for (int j = 0; j < 4; ++j) x[k][j] = x[k][j] * ir[k] * gi1[j] + v[k][j] * rs * gv2[j];
                store_row_bf16(X1B + (size_t)(m + k) * D, lane, x[k]);
                const float rs2 = 1.0f / sqrtf(sumsq4(x[k]) * (1.0f / D) + EPS);
#pragma unroll
                for (int j = 0; j < 4; ++j) x[k][j] = x[k][j] * rs2 * gv3[j];
                store_row_bf16(XN + (size_t)(m + k) * D, lane, x[k]);
            }
        }
        }
        GRID_BAR();
        { bf16* XN = WP(bf16, WS_XN); bf16* W1_t = WP(bf16, WS_W1); bf16* U = WP(bf16, WS_U);
          pg8::Gemm g{XN, W1_t, CH, DFF, D}; pg8::StaticOrder S; S.init(CH, DFF, G, (int)blockIdx.x);
          pg8::Epi<4> E{U, DFF, nullptr, nullptr, nullptr, 0, 1.f};
          pg8::gemm_phase<pg8::Epi<4>, pg8::StaticOrder, true, true>(lds, g, S, E); }
        GRID_BAR();
        { bf16* U = WP(bf16, WS_U); bf16* W2_t = WP(bf16, WS_W2); bf16* Fb = WP(bf16, WS_F);
          pg8::Gemm g{U, W2_t, CH, D, DFF}; pg8::StaticOrder S; S.init(CH, D, G, (int)blockIdx.x);
          pg8::Epi<3> E{Fb, D, nullptr, nullptr, nullptr, 0, 1.f};
          pg8::gemm_phase<pg8::Epi<3>, pg8::StaticOrder, true, true>(lds, g, S, E); }
        GRID_BAR();
        { FRESH_LANE(); float* xout = XOUT(); const float* g4 = KARG(10); bf16* Fb = WP(bf16, WS_F); bf16* X1B = WP(bf16, WS_X1B);
        f32x4 gv[4];
#pragma unroll
        for (int j = 0; j < 4; ++j) gv[j] = *(const f32x4*)(g4 + 4 * lane + 256 * j);
        for (int m = gwl * RB; m < CH; m += NGW * RB) {
            f32x4 v[RB][4], x[RB][4];
#pragma unroll
            for (int k = 0; k < RB; ++k) { load_row_bf16(Fb + (size_t)(m + k) * D, lane, v[k]); load_row_bf16(X1B + (size_t)(m + k) * D, lane, x[k]); }
#pragma unroll
            for (int k = 0; k < RB; ++k) {
                const float rs = 1.0f / sqrtf(sumsq4(v[k]) * (1.0f / D) + EPS);
#pragma unroll
                for (int j = 0; j < 4; ++j) __builtin_nontemporal_store(x[k][j] + v[k][j] * rs * gv[j], (f32x4*)(xout + (size_t)(m + k) * D + 4 * lane + 256 * j));
            }
        }
        }
    }
}

extern "C" void kernel_launch(void* const* d_in, const int* in_sizes, int n_in, void* d_out, int out_size, void* d_ws, size_t ws_size, hipStream_t stream) {
    static int grid = 0;
    if (grid == 0) {
        if (n_in != 13 || out_size != TOK * D || ws_size < WS_END) { fprintf(stderr, "kernel_launch: unexpected shapes (n_in %d out %d ws %zu)\n", n_in, out_size, ws_size); grid = -1; return; }
        int dev = 0, cus = 0, per_cu = 0;
        hipGetDevice(&dev); hipDeviceGetAttribute(&cus, hipDeviceAttributeMultiprocessorCount, dev);
        if (hipFuncSetAttribute((const void*)fwd_mega, hipFuncAttributeMaxDynamicSharedMemorySize, LDS_BYTES) != hipSuccess) { fprintf(stderr, "kernel_launch: hipFuncSetAttribute failed\n"); grid = -1; return; }
        if (hipOccupancyMaxActiveBlocksPerMultiprocessor(&per_cu, (const void*)fwd_mega, NWAVES * 64, LDS_BYTES) != hipSuccess || per_cu < 1) { fprintf(stderr, "kernel_launch: occupancy query says %d\n", per_cu); per_cu = 1; }
        (void)hipGetLastError();
        grid = cus * 1;
    }
    if (grid < 0) return;
    if (hipMemsetAsync(d_ws, 0, 65536, stream) != hipSuccess) { fprintf(stderr, "kernel_launch: memset failed\n"); return; }
    Args a{};
    for (int i = 0; i < 13; ++i) a.in[i] = (const float*)d_in[i];
    a.out = (float*)d_out; a.ws = (unsigned char*)d_ws; a.cg_seams = 0;
    void* kargs[] = {&a};
    hipError_t e = hipLaunchCooperativeKernel((const void*)fwd_mega, dim3(grid), dim3(NWAVES * 64), kargs, LDS_BYTES, stream);
    if (e != hipSuccess) fprintf(stderr, "kernel_launch: cooperative launch failed: %s (grid %d)\n", hipGetErrorString(e), grid);
}
```

```cpp
#include <hip/hip_runtime.h>
#include <hip/hip_cooperative_groups.h>
#include <cstdio>
#include <cstdint>
namespace cg = cooperative_groups;
namespace pg8 {
#define PG8_LAS __attribute__((address_space(3)))
typedef unsigned short bf16_t;
typedef short bf16x8 __attribute__((ext_vector_type(8)));
typedef float f32x4 __attribute__((ext_vector_type(4)));
typedef unsigned u32x4 __attribute__((ext_vector_type(4)));
constexpr int BM = 256, BK = 64, HALF = 128, HTB = HALF * BK * 2  , STAGE_BYTES = 8 * HTB, NXCD = 8, WGM = 8;

__host__ __device__ __forceinline__ int lds_byte(int r, int c) { const int st = (r >> 4) * 2 + (c >> 5), rr = r & 15, cc = c & 31, ob = rr * 64 + cc * 2; return st * 1024 + (ob ^ (((ob >> 9) & 1) << 5)); }
__host__ __device__ __forceinline__ void stage_rc(int b, int& R, int& C) { const int st = b / 1024, sb = b % 1024, swz = sb ^ (((sb >> 9) & 1) << 5); R = (st >> 1) * 16 + swz / 64; C = (st & 1) * 32 + (swz % 64) / 2; }
__host__ __device__ __forceinline__ int perm32(int rho) { const int n = rho >> 4, i = rho & 15; return 8 * (i >> 2) + 4 * n + (i & 3); }

struct Unit { int pm, pn; };
struct Gemm { const bf16_t* A; const bf16_t* Bt; int M, N, K; };

struct StaticOrder {
    int nM, nN, nwg, G, c, wgm = WGM;
    __host__ __device__ void init(int M, int N, int G_, int c_) { nM = M / BM; nN = N / BM; nwg = nM * nN; G = G_; c = c_; }
    __host__ __device__ bool next(int i, Unit& u) const {
        const long L = (long)i * G + c; if (L >= nwg) return false;
        int wgid = (int)L; { const int q = nwg / NXCD, r = nwg % NXCD, xcd = wgid % NXCD, off = wgid / NXCD; wgid = (xcd < r ? xcd * (q + 1) : r * (q + 1) + (xcd - r) * q) + off; }
        const int nig = wgm * nN, gid = wgid / nig, fm = gid * wgm, gsz = (nM - fm) < wgm ? (nM - fm) : wgm;
        u.pm = fm + ((wgid % nig) % gsz); u.pn = (wgid % nig) / gsz; return true;
    }
    __device__ __forceinline__ void a_ready(const Unit&) const {}
    __device__ __forceinline__ void done(const Unit&) const {}
};

__device__ __forceinline__ unsigned cvt_pk_bf16(float lo, float hi) { unsigned r; asm volatile("v_cvt_pk_bf16_f32 %0, %1, %2" : "=v"(r) : "v"(lo), "v"(hi)); return r; }
typedef unsigned u32x2 __attribute__((ext_vector_type(2)));
constexpr size_t ZH = (size_t)32768 * 128;
__device__ __forceinline__ float bf_lo(unsigned w) { return __builtin_bit_cast(float, w << 16); }
__device__ __forceinline__ float bf_hi(unsigned w) { return __builtin_bit_cast(float, w & 0xffff0000u); }
__device__ __forceinline__ float sigm(float x) { return __builtin_amdgcn_rcpf(1.0f + __builtin_amdgcn_exp2f(-1.4426950408889634f * x)); }
template <int MODE> struct Epi {
    static constexpr bool PERM = true, AFTER_DRAIN = false;
    static constexpr int HOOK_T = (MODE == 1) ? 16 : 0;
    __device__ __forceinline__ void hook(f32x4 (&acc)[2][2][4][2], const Unit& u, int wr, int wc, int fr, int fq) const {
        if constexpr (MODE == 1) {
            int fr_ = fr, fq_ = fq; asm volatile("" : "+v"(fr_), "+v"(fq_));
            const int row0 = u.pm * BM + wr * 64 + fr_, col0 = u.pn * BM + wc * 32 + 8 * fq_;
#pragma unroll
            for (int ai = 0; ai < 2; ++ai)
#pragma unroll
            for (int m = 0; m < 4; ++m) {
                u32x4 ga[2], gb[2];
#pragma unroll
                for (int bj = 0; bj < 2; ++bj) { const bf16_t* p = Zg + (size_t)(2 * u.pn + bj) * ZH + (size_t)(row0 + ai * HALF + m * 16) * 128 + (col0 & 127);
                    gb[bj] = *(const u32x4*)p; ga[bj] = *(const u32x4*)(p - 8 * ZH); }
                asm volatile("" ::: "memory");
#pragma unroll
                for (int bj = 0; bj < 2; ++bj) { const u32x4 a = ga[bj], b = gb[bj];
#define RAT(x, y) ((1.0f + __builtin_amdgcn_exp2f(-1.4426950408889634f * (y))) * __builtin_amdgcn_rcpf(1.0f + __builtin_amdgcn_exp2f(-1.4426950408889634f * (x))))
                    f32x4& v0 = acc[ai][bj][m][0]; f32x4& v1 = acc[ai][bj][m][1];
                    v0[0] *= RAT(bf_lo(a.x), bf_lo(b.x)); v0[1] *= RAT(bf_hi(a.x), bf_hi(b.x)); v0[2] *= RAT(bf_lo(a.y), bf_lo(b.y)); v0[3] *= RAT(bf_hi(a.y), bf_hi(b.y));
                    v1[0] *= RAT(bf_lo(a.z), bf_lo(b.z)); v1[1] *= RAT(bf_hi(a.z), bf_hi(b.z)); v1[2] *= RAT(bf_lo(a.w), bf_lo(b.w)); v1[3] *= RAT(bf_hi(a.w), bf_hi(b.w));
#undef RAT
                }
                asm volatile("" ::: "memory");
            }
        }
    }
    bf16_t* O; int ldc; const bf16_t* Zg; const float* ropeC; const float* ropeS; int lmask; float qscale;
    __device__ __forceinline__ void operator()(const f32x4 (&acc)[2][2][4][2], const Unit& u, int wr, int wc, int fr, int fq) const {
        const int row0 = u.pm * BM + wr * 64 + fr;
        const int col0 = u.pn * BM + wc * 32 + 8 * fq;
        if constexpr (MODE == 0) {
            const int pn = u.pn; const bool isg = (pn >= 6 && pn < 24); const int gm = isg ? (pn - 6) % 6 : 0;
            const bool rope_on = (pn <= 4) || (isg && gm < 4); const bool q_on = (pn < 4) || (isg && gm < 2);
            if (rope_on) {
                const float sc = q_on ? qscale : 1.0f; const int j0 = 16 * wc + 4 * fq;
                float wj[4];
#pragma unroll
                for (int i = 0; i < 4; ++i) wj[i] = __builtin_amdgcn_exp2f(-(float)(j0 + i) * (13.287712379549449f / 64.0f)) * 0.15915494309189535f;
#pragma unroll
                for (int ai = 0; ai < 2; ++ai)
#pragma unroll
                    for (int m = 0; m < 4; ++m) {
                        const int r = row0 + ai * HALF + m * 16; const float pos = (float)(r & lmask);
                        f32x4 c, s;
#pragma unroll
                        for (int i = 0; i < 4; ++i) { const float x = __builtin_amdgcn_fractf(pos * wj[i]); c[i] = __builtin_amdgcn_cosf(x) * sc; s[i] = __builtin_amdgcn_sinf(x) * sc; }
#pragma unroll
                        for (int bj = 0; bj < 2; ++bj) {
                            const f32x4 t1 = acc[ai][bj][m][0], t2 = acc[ai][bj][m][1];
                            const f32x4 o1 = t1 * c - t2 * s, o2 = t1 * s + t2 * c;
                            bf16_t* p = O + (size_t)(2 * pn + bj) * ZH + (size_t)r * 128 + (col0 & 127);
                            u32x4 w; w.x = cvt_pk_bf16(o1[0], o1[1]); w.y = cvt_pk_bf16(o1[2], o1[3]); w.z = cvt_pk_bf16(o2[0], o2[1]); w.w = cvt_pk_bf16(o2[2], o2[3]);
                            __builtin_nontemporal_store(w, (u32x4*)p);
                        }
                    }
                return;
            }
        }
        constexpr int MB = (MODE == 2) ? 2 : 4;
#pragma unroll
        for (int ai = 0; ai < 2; ++ai)
#pragma unroll
        for (int mb = 0; mb < 4; mb += MB) {
            u32x4 gt[MB][2], og[MB][2];
            if constexpr (MODE == 1 || MODE == 2) {
#pragma unroll
                for (int m = 0; m < MB; ++m)
#pragma unroll
                    for (int bj = 0; bj < 2; ++bj) { const int r = row0 + ai * HALF + (mb + m) * 16;
                        gt[m][bj] = *(const u32x4*)(Zg + (size_t)(2 * u.pn + bj) * ZH + (size_t)r * 128 + (col0 & 127));
                        if constexpr (MODE == 2) og[m][bj] = *(const u32x4*)(O + (size_t)r * ldc + col0 + bj * HALF); }
                asm volatile("" ::: "memory");
            }
#pragma unroll
            for (int mm = 0; mm < MB; ++mm) {
                const int m = mb + mm;
                const int r = row0 + ai * HALF + m * 16;
#pragma unroll
                for (int bj = 0; bj < 2; ++bj) {
                    f32x4 v0 = acc[ai][bj][m][0], v1 = acc[ai][bj][m][1];
                    bf16_t* p = (MODE == 0) ? O + (size_t)(2 * u.pn + bj) * ZH + (size_t)r * 128 + (col0 & 127) : O + (size_t)r * ldc + col0 + bj * HALF;
                    if constexpr (MODE == 1 || MODE == 2) {
                        const u32x4 g = gt[mm][bj];
                        v0[0] *= sigm(bf_lo(g.x)); v0[1] *= sigm(bf_hi(g.x)); v0[2] *= sigm(bf_lo(g.y)); v0[3] *= sigm(bf_hi(g.y));
                        v1[0] *= sigm(bf_lo(g.z)); v1[1] *= sigm(bf_hi(g.z)); v1[2] *= sigm(bf_lo(g.w)); v1[3] *= sigm(bf_hi(g.w));
                        if constexpr (MODE == 2) {
                            const u32x4 o = og[mm][bj];
                            v0[0] += bf_lo(o.x); v0[1] += bf_hi(o.x); v0[2] += bf_lo(o.y); v0[3] += bf_hi(o.y);
                            v1[0] += bf_lo(o.z); v1[1] += bf_hi(o.z); v1[2] += bf_lo(o.w); v1[3] += bf_hi(o.w);
                        }
                    }
                    if constexpr (MODE == 4) {
#pragma unroll
                        for (int i = 0; i < 4; ++i) { const float a = fmaxf(v0[i], 0.f), b = fmaxf(v1[i], 0.f); v0[i] = a * a; v1[i] = b * b; }
                    }
                    u32x4 w; w.x = cvt_pk_bf16(v0[0], v0[1]); w.y = cvt_pk_bf16(v0[2], v0[3]); w.z = cvt_pk_bf16(v1[0], v1[1]); w.w = cvt_pk_bf16(v1[2], v1[3]);
                    if constexpr (MODE == 0 || MODE == 4) __builtin_nontemporal_store(w, (u32x4*)p); else *(u32x4*)p = w;
                }
            }
        }
    }
};
template <class Epi, class Sched, bool ALIGN_EPI = false, bool SP2 = false>
__device__ __forceinline__ void gemm_phase(PG8_LAS unsigned char* lds, const Gemm g, const Sched& S, const Epi& E) {
    int tid_ = threadIdx.x; asm volatile("" : "+v"(tid_));
    const int tid = tid_, wid = __builtin_amdgcn_readfirstlane(tid >> 6), lane = tid & 63, wr = wid >> 2, wc = wid & 3, fr = lane & 15, fq = lane >> 4;
    const int K = g.K, nt = K / BK;
    unsigned voffA[2], voffB[2];
#pragma unroll
    for (int i = 0; i < 2; ++i) { int R, C; stage_rc(tid * 16 + i * 8192, R, C); const int Rb = Epi::PERM ? ((R & ~31) + perm32(R & 31)) : R;
        voffA[i] = (unsigned)(R * K + C) * 2u; voffB[i] = (unsigned)(Rb * K + C) * 2u; }
    const size_t kstep = (size_t)(BK * 2);
    const size_t hstep = (size_t)HALF * K * 2;
    const size_t tstep = 2 * hstep;
    const unsigned ldsw = (unsigned)wid * 1024u;
    const int aoff = lds_byte(wr * 64 + fr, fq * 8), boff = lds_byte(wc * 32 + fr, fq * 8);
#define PG8_SA(b, h) (((b) * 2 + (h)) * HTB)
#define PG8_SB(b, h) ((4 + (b) * 2 + (h)) * HTB)
#define PG8_STAGE(bufoff, gbase, voff) do { _Pragma("unroll") for (int _i = 0; _i < 2; ++_i) \
        __builtin_amdgcn_global_load_lds((const unsigned*)((const char*)(gbase) + (voff)[_i]), (PG8_LAS unsigned*)(lds + (bufoff) + ldsw + _i * 8192), 16, 0, 0); } while (0)
#define PG8_LDA(dst, b, h) do { _Pragma("unroll") for (int m = 0; m < 4; ++m) _Pragma("unroll") for (int k = 0; k < 2; ++k) dst[m][k] = *(const PG8_LAS bf16x8*)(lds + PG8_SA(b, h) + aoff + m * 2048 + k * 1024); } while (0)
#define PG8_LDB(dst, b, h) do { _Pragma("unroll") for (int n = 0; n < 2; ++n) _Pragma("unroll") for (int k = 0; k < 2; ++k) dst[n][k] = *(const PG8_LAS bf16x8*)(lds + PG8_SB(b, h) + boff + n * 2048 + k * 1024); } while (0)
#define PG8_MMA(ai, bj, At, Bt) do { __builtin_amdgcn_s_setprio(1); _Pragma("unroll") for (int m = 0; m < 4; ++m) _Pragma("unroll") for (int n = 0; n < 2; ++n) _Pragma("unroll") for (int k = 0; k < 2; ++k) \
        acc[ai][bj][m][n] = __builtin_amdgcn_mfma_f32_16x16x32_bf16(Bt[n][k], At[m][k], acc[ai][bj][m][n], 0, 0, 0); __builtin_amdgcn_s_setprio(0); } while (0)
#define PG8_WAIT_V(n) asm volatile("s_waitcnt vmcnt(" #n ")" ::: "memory")
#define PG8_WAIT_L(n) asm volatile("s_waitcnt lgkmcnt(" #n ")" ::: "memory")
#define PG8_BAR __builtin_amdgcn_s_barrier()
#define PG8_SCHED __builtin_amdgcn_sched_barrier(0)
    Unit cur, nxt; int ui = 0;
    if (!S.next(0, cur)) return;
    f32x4 acc[2][2][4][2];
#pragma unroll
    for (int a = 0; a < 2; ++a)
#pragma unroll
        for (int b = 0; b < 2; ++b)
#pragma unroll
            for (int m = 0; m < 4; ++m)
#pragma unroll
                for (int n = 0; n < 2; ++n) acc[a][b][m][n] = (f32x4){0.f, 0.f, 0.f, 0.f};
    bf16x8 At[4][2], B0[2][2], B1[2][2];
    const char* cA = (const char*)g.A + (size_t)cur.pm * tstep; const char* cB = (const char*)g.Bt + (size_t)cur.pn * tstep;
    S.a_ready(cur);
    if constexpr (SP2) {
        PG8_STAGE(PG8_SB(0, 0), cB, voffB); PG8_STAGE(PG8_SB(0, 1), cB + hstep, voffB); PG8_STAGE(PG8_SA(0, 0), cA, voffA); PG8_STAGE(PG8_SA(0, 1), cA + hstep, voffA);
        if (wr == 1) PG8_BAR;
        PG8_WAIT_V(2); PG8_BAR;
        PG8_STAGE(PG8_SB(1, 0), cB + kstep, voffB); PG8_STAGE(PG8_SA(1, 0), cA + kstep, voffA); PG8_STAGE(PG8_SB(1, 1), cB + hstep + kstep, voffB);
        PG8_WAIT_V(6); PG8_BAR;
    } else {
        PG8_STAGE(PG8_SB(0, 0), cB, voffB); PG8_STAGE(PG8_SA(0, 0), cA, voffA); PG8_STAGE(PG8_SB(0, 1), cB + hstep, voffB); PG8_STAGE(PG8_SA(0, 1), cA + hstep, voffA);
        if (wr == 1) PG8_BAR;
        PG8_WAIT_V(4); PG8_BAR;
        PG8_STAGE(PG8_SB(1, 0), cB + kstep, voffB); PG8_STAGE(PG8_SA(1, 0), cA + kstep, voffA); PG8_STAGE(PG8_SB(1, 1), cB + hstep + kstep, voffB);
        PG8_WAIT_V(6); PG8_BAR;
    }
    for (;;) {
        const bool has_next = S.next(ui + 1, nxt);
        const char* nA = has_next ? (const char*)g.A + (size_t)nxt.pm * tstep : cA; const char* nB = has_next ? (const char*)g.Bt + (size_t)nxt.pn * tstep : cB;
        for (int t = 0; t < nt; t += 2) {
            const bool last = (t == nt - 2);
            const char* a1 = cA + (size_t)(t + 1) * kstep;
            const char* a2 = last ? nA : cA + (size_t)(t + 2) * kstep; const char* b2 = last ? nB : cB + (size_t)(t + 2) * kstep;
            const char* a3 = a2 + kstep; const char* b3 = b2 + kstep;
            if (last && has_next) S.a_ready(nxt);
            if constexpr (Epi::HOOK_T > 0) { if (t == Epi::HOOK_T) E.hook(acc, cur, wr, wc, fr, fq); }
            if constexpr (SP2) {
            PG8_LDB(B0, 0, 0); PG8_LDB(B1, 0, 1); PG8_SCHED; PG8_LDA(At, 0, 0); PG8_STAGE(PG8_SA(1, 1), a1 + hstep, voffA);
            PG8_WAIT_V(8); PG8_WAIT_L(0); PG8_BAR; PG8_MMA(0, 0, At, B0); PG8_MMA(0, 1, At, B1); PG8_BAR; PG8_SCHED;
            PG8_LDA(At, 0, 1); PG8_STAGE(PG8_SB(0, 0), b2, voffB); PG8_STAGE(PG8_SB(0, 1), b2 + hstep, voffB); PG8_STAGE(PG8_SA(0, 0), a2, voffA);
            PG8_WAIT_V(8); PG8_WAIT_L(0); PG8_BAR; PG8_MMA(1, 0, At, B0); PG8_MMA(1, 1, At, B1); PG8_BAR; PG8_SCHED;
            PG8_LDB(B0, 1, 0); PG8_LDB(B1, 1, 1); PG8_SCHED; PG8_LDA(At, 1, 0); PG8_STAGE(PG8_SA(0, 1), a2 + hstep, voffA);
            PG8_WAIT_V(8); PG8_WAIT_L(0); PG8_BAR; PG8_MMA(0, 0, At, B0); PG8_MMA(0, 1, At, B1); PG8_BAR; PG8_SCHED;
            PG8_LDA(At, 1, 1); PG8_STAGE(PG8_SB(1, 0), b3, voffB); PG8_STAGE(PG8_SB(1, 1), b3 + hstep, voffB); PG8_STAGE(PG8_SA(1, 0), a3, voffA);
            PG8_WAIT_V(8); PG8_WAIT_L(0); PG8_BAR; PG8_MMA(1, 0, At, B0); PG8_MMA(1, 1, At, B1); PG8_BAR; PG8_SCHED;
            } else {
            PG8_LDB(B0, 0, 0); PG8_SCHED; PG8_LDA(At, 0, 0); PG8_STAGE(PG8_SA(1, 1), a1 + hstep, voffA);
            PG8_WAIT_L(8); PG8_BAR; PG8_WAIT_L(0); PG8_MMA(0, 0, At, B0); PG8_BAR; PG8_SCHED;
            PG8_LDB(B1, 0, 1); PG8_STAGE(PG8_SB(0, 0), b2, voffB);
            PG8_BAR; PG8_WAIT_L(0); PG8_MMA(0, 1, At, B1); PG8_BAR;
            PG8_LDA(At, 0, 1); PG8_STAGE(PG8_SA(0, 0), a2, voffA);
            PG8_BAR; PG8_WAIT_L(0); PG8_MMA(1, 0, At, B0); PG8_BAR; PG8_SCHED;
            PG8_STAGE(PG8_SB(0, 1), b2 + hstep, voffB);
            PG8_WAIT_V(6); PG8_BAR; PG8_MMA(1, 1, At, B1); PG8_BAR;
            PG8_LDB(B0, 1, 0); PG8_SCHED; PG8_LDA(At, 1, 0); PG8_STAGE(PG8_SA(0, 1), a2 + hstep, voffA);
            PG8_WAIT_L(8); PG8_BAR; PG8_WAIT_L(0); PG8_MMA(0, 0, At, B0); PG8_BAR; PG8_SCHED;
            PG8_LDB(B1, 1, 1); PG8_STAGE(PG8_SB(1, 0), b3, voffB);
            PG8_BAR; PG8_WAIT_L(0); PG8_MMA(0, 1, At, B1); PG8_BAR;
            PG8_LDA(At, 1, 1); PG8_STAGE(PG8_SA(1, 0), a3, voffA);
            PG8_BAR; PG8_WAIT_L(0); PG8_MMA(1, 0, At, B0); PG8_BAR; PG8_SCHED;
            PG8_STAGE(PG8_SB(1, 1), b3 + hstep, voffB);
            PG8_WAIT_V(6); PG8_BAR; PG8_MMA(1, 1, At, B1); PG8_BAR;
            }
        }
        if constexpr (ALIGN_EPI) { if (wr == 0) PG8_BAR; }
        if constexpr (!Epi::AFTER_DRAIN) { E(acc, cur, wr, wc, fr, fq); S.done(cur); }
        if (!has_next) break;
#pragma unroll
        for (int a = 0; a < 2; ++a)
#pragma unroll
            for (int b = 0; b < 2; ++b)
#pragma unroll
                for (int m = 0; m < 4; ++m)
#pragma unroll
                    for (int n = 0; n < 2; ++n) acc[a][b][m][n] = (f32x4){0.f, 0.f, 0.f, 0.f};
        cur = nxt; cA = nA; cB = nB; ++ui;
        if constexpr (ALIGN_EPI) { if (wr == 1) PG8_BAR; }
    }
    PG8_WAIT_V(0);
    if constexpr (!ALIGN_EPI) { if (wr == 0) PG8_BAR; }
    PG8_BAR;
    if constexpr (Epi::AFTER_DRAIN) { E.fused(acc, cur, wr, wc, fr, fq, lds, wid, lane); S.done(cur); }
#undef PG8_SA
#undef PG8_SB
#undef PG8_STAGE
#undef PG8_LDA
#undef PG8_LDB
#undef PG8_MMA
#undef PG8_WAIT_V
#undef PG8_WAIT_L
#undef PG8_BAR
#undef PG8_SCHED
}
}
namespace att {
#define ATT_LAS __attribute__((address_space(3)))
typedef unsigned short bf16_t;
typedef short bf16x8 __attribute__((ext_vector_type(8)));
typedef short s16x4 __attribute__((ext_vector_type(4)));
typedef float f32x16 __attribute__((ext_vector_type(16)));
typedef unsigned u32x4 __attribute__((ext_vector_type(4)));
constexpr size_t ZH = (size_t)32768 * 128;
#define KSWZ(row, colB) ((row) * 256 + ((colB) ^ (((row) & 7) << 4)))
#define SBAR() __builtin_amdgcn_sched_barrier(0)
__device__ __forceinline__ int crow(int r, int hi) { return (r & 3) + 8 * (r >> 2) + 4 * hi; }
__device__ __forceinline__ unsigned cvtpk(float lo, float hi) { unsigned r; asm volatile("v_cvt_pk_bf16_f32 %0, %1, %2" : "=v"(r) : "v"(lo), "v"(hi)); return r; }
__device__ __forceinline__ int v_st(int k, int c) { const int kk = (k & ~0xC) | ((k & 4) << 1) | ((k & 8) >> 1); return ((kk >> 3) * 4 + (c >> 5)) * 512 + ((kk & 7) * 32 + (c & 31)) * 2; }
__device__ __forceinline__ int v_rd_base(int lane) { return ((lane & 3) << 3) | (((lane >> 2) & 3) << 6) | (((lane >> 4) & 1) << 5) | (((lane >> 5) & 1) << 8); }
constexpr int v_rd_off(int d0, int ks, int half) { return d0 * 512 + ks * 4096 + half * 2048; }
template <int OFF> __device__ __forceinline__ s16x4 tr_read(unsigned vb) { s16x4 r; asm volatile("ds_read_b64_tr_b16 %0, %1 offset:%2" : "=&v"(r) : "v"(vb), "i"(OFF) : "memory"); return r; }
template <int D0> __device__ __forceinline__ void pv_one(f32x16& od, unsigned vb, bf16x8 pa0, bf16x8 pa1, bf16x8 pa2, bf16x8 pa3) {
  const s16x4 l0 = tr_read<v_rd_off(D0, 0, 0)>(vb), h0 = tr_read<v_rd_off(D0, 0, 1)>(vb), l1 = tr_read<v_rd_off(D0, 1, 0)>(vb), h1 = tr_read<v_rd_off(D0, 1, 1)>(vb);
  const s16x4 l2 = tr_read<v_rd_off(D0, 2, 0)>(vb), h2 = tr_read<v_rd_off(D0, 2, 1)>(vb), l3 = tr_read<v_rd_off(D0, 3, 0)>(vb), h3 = tr_read<v_rd_off(D0, 3, 1)>(vb);
  asm volatile("s_waitcnt lgkmcnt(0)" ::: "memory"); SBAR();
#define PK(L, H) (bf16x8){L[0], L[1], L[2], L[3], H[0], H[1], H[2], H[3]}
  od = __builtin_amdgcn_mfma_f32_32x32x16_bf16(pa0, PK(l0, h0), od, 0, 0, 0);
  od = __builtin_amdgcn_mfma_f32_32x32x16_bf16(pa1, PK(l1, h1), od, 0, 0, 0);
  od = __builtin_amdgcn_mfma_f32_32x32x16_bf16(pa2, PK(l2, h2), od, 0, 0, 0);
  od = __builtin_amdgcn_mfma_f32_32x32x16_bf16(pa3, PK(l3, h3), od, 0, 0, 0);
#undef PK
}
template <int D0> __device__ __forceinline__ void rd8(unsigned vb, s16x4 (&r)[8]) {
  r[0] = tr_read<v_rd_off(D0, 0, 0)>(vb); r[1] = tr_read<v_rd_off(D0, 0, 1)>(vb); r[2] = tr_read<v_rd_off(D0, 1, 0)>(vb); r[3] = tr_read<v_rd_off(D0, 1, 1)>(vb);
  r[4] = tr_read<v_rd_off(D0, 2, 0)>(vb); r[5] = tr_read<v_rd_off(D0, 2, 1)>(vb); r[6] = tr_read<v_rd_off(D0, 3, 0)>(vb); r[7] = tr_read<v_rd_off(D0, 3, 1)>(vb);
}
__device__ __forceinline__ void mm4(f32x16& od, bf16x8 pa0, bf16x8 pa1, bf16x8 pa2, bf16x8 pa3, const s16x4 (&r)[8]) {
#define PK(L, H) (bf16x8){L[0], L[1], L[2], L[3], H[0], H[1], H[2], H[3]}
  od = __builtin_amdgcn_mfma_f32_32x32x16_bf16(pa0, PK(r[0], r[1]), od, 0, 0, 0);
  od = __builtin_amdgcn_mfma_f32_32x32x16_bf16(pa1, PK(r[2], r[3]), od, 0, 0, 0);
  od = __builtin_amdgcn_mfma_f32_32x32x16_bf16(pa2, PK(r[4], r[5]), od, 0, 0, 0);
  od = __builtin_amdgcn_mfma_f32_32x32x16_bf16(pa3, PK(r[6], r[7]), od, 0, 0, 0);
#undef PK
}
__device__ __forceinline__ void pv_all(f32x16 (&o)[4], unsigned vb, bf16x8 pa0, bf16x8 pa1, bf16x8 pa2, bf16x8 pa3) {
  s16x4 A[8], B[8];
  rd8<0>(vb, A); rd8<1>(vb, B);
  asm volatile("s_waitcnt lgkmcnt(8)" ::: "memory"); SBAR();
  mm4(o[0], pa0, pa1, pa2, pa3, A); SBAR();
  rd8<2>(vb, A);
  asm volatile("s_waitcnt lgkmcnt(8)" ::: "memory"); SBAR();
  mm4(o[1], pa0, pa1, pa2, pa3, B); SBAR();
  rd8<3>(vb, B);
  asm volatile("s_waitcnt lgkmcnt(8)" ::: "memory"); SBAR();
  mm4(o[2], pa0, pa1, pa2, pa3, A); SBAR();
  asm volatile("s_waitcnt lgkmcnt(0)" ::: "memory"); SBAR();
  mm4(o[3], pa0, pa1, pa2, pa3, B);
}
__device__ __forceinline__ void qkt(f32x16& p0, f32x16& p1, const ATT_LAS unsigned char* Ks, const bf16x8* qr, int r32, int hi) {
  p0 = f32x16{}; p1 = f32x16{};
#pragma unroll
  for (int d0 = 0; d0 < 8; ++d0) { const int cb = (d0 * 16 + hi * 8) * 2;
    const bf16x8 b0 = *(const ATT_LAS bf16x8*)(Ks + KSWZ(r32, cb));
    const bf16x8 b1 = *(const ATT_LAS bf16x8*)(Ks + KSWZ(32 + r32, cb));
    p0 = __builtin_amdgcn_mfma_f32_32x32x16_bf16(b0, qr[d0], p0, 0, 0, 0);
    p1 = __builtin_amdgcn_mfma_f32_32x32x16_bf16(b1, qr[d0], p1, 0, 0, 0); }
}
struct Desc { int tbase, dil, Lf, q0, qcol0, kcol0, g; float m0, m1; };
template <int NS> __device__ __forceinline__ Desc decode(int it, int L, int lgq, const float* sink) {
  Desc d; const int nqb = 1 << lgq;
  if constexpr (NS == 1) {
    const int pr = it & 1, kvh = (it >> 1) & 1, qbs = it >> 2, s = qbs >> lgq, qb = qbs & (nqb - 1), h0 = kvh * 4 + pr * 2;
    d.tbase = s * L; d.dil = 1; d.Lf = L; d.q0 = qb * 128; d.qcol0 = h0 * 128; d.kcol0 = 1024 + kvh * 128; d.g = 0;
    d.m0 = sink[h0] * 1.4426950408889634f; d.m1 = sink[h0 + 1] * 1.4426950408889634f;
  } else {
    const int g = it >> 9, jj = it & 511, pr = jj & 1, rest = jj >> 1;
    const int lgd = 2 * g, lgn = lgq - lgd;
    const int s = rest >> lgq, rr = rest & (nqb - 1), res = rr >> lgn, qb = rr & ((1 << lgn) - 1), cb = 1536 + g * 1536 + pr * 256;
    d.tbase = s * L + res; d.dil = 1 << lgd; d.Lf = L >> lgd; d.q0 = qb * 128; d.qcol0 = cb; d.kcol0 = cb + 512; d.g = g;
    d.m0 = -1e30f; d.m1 = -1e30f;
  }
  return d;
}
template <int NS>
__device__ __forceinline__ void attn_items(ATT_LAS unsigned char* lds, const bf16_t* __restrict__ Z, int first, int limit, int stride, int L, const float* sink,
                                           bf16_t* __restrict__ Obase, size_t ogstride, int opitch, float* __restrict__ lsebase, size_t lgstride) {
  if (first >= limit) return;
  constexpr int HW = (NS == 1) ? 128 : 64, NT = (128 + 2 * HW) / 64;
  constexpr float L_INIT = (NS == 1) ? 1.0f : 0.0f; constexpr int VD = (NS == 1) ? 256 : 512;
  int tid_ = threadIdx.x; asm volatile("" : "+v"(tid_));
  const int tid = tid_, wid = __builtin_amdgcn_readfirstlane(tid >> 6), lane = tid & 63, r32 = lane & 31, hi = lane >> 5;
  const int qi = wid & 3, grp = wid >> 2, strm = (NS == 2) ? grp : 0;
  const ATT_LAS unsigned char* Kl = lds + strm * 32768;
  ATT_LAS float* li_l = (ATT_LAS float*)(lds + 131072 + 512) + wid * 64; ATT_LAS float* al_l = li_l + 32;
  const int sr = tid >> 4, sc = (tid & 15) * 8;
  const int vst0 = v_st(sr, sc), vst1 = v_st(32 + sr, sc), kst0 = KSWZ(sr, sc * 2), kst1 = KSWZ(32 + sr, sc * 2);
  const unsigned vb0 = (unsigned)(size_t)(lds + strm * 32768 + 16384) + (unsigned)v_rd_base(lane);
  constexpr int BUFSZ = NS * 32768;
  bf16x8 qr[8]; bf16x8 stg[NS][4];
#define ALOAD(D_, t) do { int k0_ = (D_).q0 - HW + (t) * 64 + sr, k1_ = k0_ + 32; k0_ = k0_ < 0 ? 0 : (k0_ > (D_).Lf - 1 ? (D_).Lf - 1 : k0_); k1_ = k1_ < 0 ? 0 : (k1_ > (D_).Lf - 1 ? (D_).Lf - 1 : k1_); \
    const bf16_t* p0_ = Z + (size_t)((D_).kcol0 >> 7) * ZH + (size_t)((D_).tbase + k0_ * (D_).dil) * 128 + sc; const bf16_t* p1_ = Z + (size_t)((D_).kcol0 >> 7) * ZH + (size_t)((D_).tbase + k1_ * (D_).dil) * 128 + sc; \
    _Pragma("unroll") for (int s_ = 0; s_ < NS; ++s_) { stg[s_][0] = *(const bf16x8*)(p0_ + s_ * ZH); stg[s_][1] = *(const bf16x8*)(p1_ + s_ * ZH); \
      stg[s_][2] = *(const bf16x8*)(p0_ + (VD / 128 + s_) * ZH); stg[s_][3] = *(const bf16x8*)(p1_ + (VD / 128 + s_) * ZH); } } while (0)
#define AWRITE(b) do { _Pragma("unroll") for (int s = 0; s < NS; ++s) { ATT_LAS unsigned char* bb_ = lds + (b) * BUFSZ + s * 32768; \
      *(ATT_LAS bf16x8*)(bb_ + kst0) = stg[s][0]; *(ATT_LAS bf16x8*)(bb_ + kst1) = stg[s][1]; \
      *(ATT_LAS bf16x8*)(bb_ + 16384 + vst0) = stg[s][2]; *(ATT_LAS bf16x8*)(bb_ + 16384 + vst1) = stg[s][3]; } } while (0)
#define QLOAD(D_) do { const bf16_t* Qw_ = Z + (size_t)(((D_).qcol0 >> 7) + grp) * ZH + (size_t)((D_).tbase + ((D_).q0 + 32 * qi + r32) * (D_).dil) * 128 + hi * 8; \
    _Pragma("unroll") for (int d0 = 0; d0 < 8; ++d0) qr[d0] = *(const bf16x8*)(Qw_ + d0 * 16); } while (0)
  const int lgq = (L == 2048) ? 4 : 5;
#define TFIRST(D_) (((D_).q0 - HW) < 0 ? ((HW - (D_).q0) >> 6) : 0)
#define TLAST(D_) ((((D_).Lf - 1 - ((D_).q0 - HW)) >> 6) < NT - 1 ? (((D_).Lf - 1 - ((D_).q0 - HW)) >> 6) : NT - 1)
  Desc cur = decode<NS>(first, L, lgq, sink);
  QLOAD(cur); ALOAD(cur, TFIRST(cur));
  for (int it = first; it < limit; it += stride) {
    const int itn = it + stride < limit ? it + stride : it;
    const int tbase = cur.tbase, dil = cur.dil, Lf = cur.Lf, q0 = cur.q0;
    const int kstart = q0 - HW, qa = q0 + 32 * qi;
    float m_reg = grp ? cur.m1 : cur.m0, l_reg = L_INIT;
    bool ozero = true;
    f32x16 o[4];
#pragma unroll
    for (int d = 0; d < 4; ++d) o[d] = f32x16{};
    __syncthreads();
    AWRITE(0); __syncthreads();
    const int wlo = qa - HW > 0 ? qa - HW : 0, whi = qa + 31 + HW < Lf - 1 ? qa + 31 + HW : Lf - 1;
    const int qpos = qa + r32;
    const int vlo = (qpos - HW > 0 ? qpos - HW : 0), vhi = (qpos + HW < Lf - 1 ? qpos + HW : Lf - 1);
    const int t0 = TFIRST(cur), t1 = TLAST(cur);
#pragma unroll 1
    for (int t = t0; t <= t1; ++t) {
      const int b = (t - t0) & 1; const bool last = (t == t1);
      if (!last) ALOAD(cur, t + 1); else { const Desc nx = decode<NS>(itn, L, lgq, sink); ALOAD(nx, TFIRST(nx)); }
      const int tlo = kstart + 64 * t, thi = tlo + 63;
      if (tlo <= whi && thi >= wlo) {
        f32x16 p0, p1;
        qkt(p0, p1, Kl + b * BUFSZ, qr, r32, hi);
        const bool interior = (tlo >= qa + 31 - HW) && (thi <= qa + HW) && (tlo >= 0) && (thi < Lf);
        if (!interior) {
          const int lo = vlo - tlo - 4 * hi, up = vhi - tlo - 4 * hi;
#pragma unroll
          for (int r = 0; r < 16; ++r) { const int c = (r & 3) + 8 * (r >> 2);
            p0[r] = (c >= lo && c <= up) ? p0[r] : -INFINITY; p1[r] = (c + 32 >= lo && c + 32 <= up) ? p1[r] : -INFINITY; }
        }
        float pmax = p0[0];
#pragma unroll
        for (int r = 1; r < 16; ++r) pmax = fmaxf(pmax, p0[r]);
#pragma unroll
        for (int r = 0; r < 16; ++r) pmax = fmaxf(pmax, p1[r]);
        { auto rr = __builtin_amdgcn_permlane32_swap(__float_as_uint(pmax), __float_as_uint(pmax), false, false);
          pmax = fmaxf(__uint_as_float(rr[0]), __uint_as_float(rr[1])); }
        float mn = m_reg, alpha = 1.f;
        const bool grow = !__all(pmax - m_reg <= 8.0f);
        if (grow) { mn = fmaxf(m_reg, pmax); alpha = __builtin_amdgcn_exp2f(m_reg - mn); m_reg = mn; }
        float ps = 0.f;
#pragma unroll
        for (int r = 0; r < 16; ++r) { p0[r] = __builtin_amdgcn_exp2f(p0[r] - mn); p1[r] = __builtin_amdgcn_exp2f(p1[r] - mn); ps += p0[r] + p1[r]; }
        { auto rr = __builtin_amdgcn_permlane32_swap(__float_as_uint(ps), __float_as_uint(ps), false, false);
          ps = __uint_as_float(rr[0]) + __uint_as_float(rr[1]); }
        l_reg = l_reg * alpha + ps;
        bf16x8 pa0, pa1, pa2, pa3;
#define PK4(P, BASE, OUT) do { unsigned a0 = cvtpk(P[BASE + 0], P[BASE + 1]), a1 = cvtpk(P[BASE + 2], P[BASE + 3]);   \
    unsigned b0 = cvtpk(P[BASE + 4], P[BASE + 5]), b1 = cvtpk(P[BASE + 6], P[BASE + 7]);                              \
    auto r0 = __builtin_amdgcn_permlane32_swap(a0, b0, false, false); auto r1 = __builtin_amdgcn_permlane32_swap(a1, b1, false, false); \
    u32x4 w = {r0[0], r1[0], r0[1], r1[1]}; OUT = __builtin_bit_cast(bf16x8, w); } while (0)
        PK4(p0, 0, pa0); PK4(p0, 8, pa1); PK4(p1, 0, pa2); PK4(p1, 8, pa3);
#undef PK4
        if (grow && !ozero && __any(alpha < 1.f)) { if (hi == 0) al_l[r32] = alpha; asm volatile("s_waitcnt lgkmcnt(0)" ::: "memory");
#pragma unroll
          for (int r = 0; r < 16; ++r) { const float a = al_l[crow(r, hi)];
#pragma unroll
            for (int d = 0; d < 4; ++d) o[d][r] *= a; } }
        const unsigned vb = vb0 + b * BUFSZ;
        if constexpr (NS == 1) pv_all(o, vb, pa0, pa1, pa2, pa3);
        else { pv_one<0>(o[0], vb, pa0, pa1, pa2, pa3); pv_one<1>(o[1], vb, pa0, pa1, pa2, pa3); pv_one<2>(o[2], vb, pa0, pa1, pa2, pa3); pv_one<3>(o[3], vb, pa0, pa1, pa2, pa3); }
        ozero = false;
      }
      if (!last) { AWRITE(b ^ 1); __syncthreads(); }
    }
    const Desc nxt = decode<NS>(itn, L, lgq, sink);
    QLOAD(nxt);
    if (hi == 0) li_l[r32] = l_reg; asm volatile("s_waitcnt lgkmcnt(0)" ::: "memory");
    const int ocol0 = (NS == 1) ? cur.qcol0 : cur.qcol0 - 1536 - cur.g * 1536;
    bf16_t* Ow = Obase + (size_t)cur.g * ogstride + ocol0 + grp * 128 + r32;
#pragma unroll
    for (int r = 0; r < 16; ++r) { const int orow = crow(r, hi); const float rl = __builtin_amdgcn_rcpf(li_l[orow]);
      bf16_t* op = Ow + (size_t)(tbase + (qa + orow) * dil) * opitch;
#pragma unroll
      for (int d0 = 0; d0 < 4; ++d0) op[d0 * 32] = (bf16_t)(cvtpk(o[d0][r] * rl, 0.f) & 0xffffu); }
    if (NS == 2 && hi == 0) lsebase[(size_t)cur.g * lgstride + (size_t)(tbase + (qa + r32) * dil) * 4 + (ocol0 >> 7) + grp] = m_reg + __builtin_amdgcn_logf(l_reg);
    cur = nxt;
  }
#undef ALOAD
#undef AWRITE
#undef QLOAD
#undef TFIRST
#undef TLAST
}
}
#define GAS __attribute__((address_space(1)))
#define LAS __attribute__((address_space(3)))
typedef unsigned short bf16;
typedef unsigned v4u __attribute__((ext_vector_type(4)));
typedef unsigned v2u __attribute__((ext_vector_type(2)));
typedef float f32x4 __attribute__((ext_vector_type(4)));
constexpr int NWAVES = 8, RB = 4;
constexpr int D = 1024, DIN = 8192, DFF = 4096, TOK = 98304, CH = 32768, NCHUNK = 3;
static_assert(pg8::ZH == (size_t)CH * 128 && att::ZH == pg8::ZH, "Z head-major block size");
constexpr float EPS = 1e-6f;
constexpr size_t MiB = 1u << 20;
constexpr size_t WS_WIN = 1 * MiB, WS_WA = 17 * MiB, WS_WB = 19 * MiB, WS_WO = 20 * MiB, WS_W1 = 22 * MiB, WS_W2 = 30 * MiB, WS_RC = 38 * MiB, WS_RS = 39 * MiB;
constexpr size_t WS_XN = 40 * MiB, WS_Z = 104 * MiB, WS_U = WS_Z, WS_OAB = 616 * MiB, WS_F = WS_OAB, WS_OB3 = 712 * MiB, WS_MIX = WS_OB3, WS_LSE = 808 * MiB, WS_G = 810 * MiB, WS_X1B = WS_G, WS_RS1 = 809 * MiB + 512 * 1024, WS_END = 874 * MiB;
constexpr int RING_BYTES = 131072, LDS_BYTES = 147456;

__device__ __forceinline__ unsigned f2bf(float f) { unsigned u = __builtin_bit_cast(unsigned, f); return (u + 0x7fffu + ((u >> 16) & 1u)) >> 16; }
__device__ __forceinline__ unsigned pk2(float lo, float hi) { return f2bf(lo) | (f2bf(hi) << 16); }
__device__ __forceinline__ float wave_sum(float v) {
#pragma unroll
    for (int o = 1; o < 64; o <<= 1) v += __shfl_xor(v, o);
    return v;
}
__device__ __forceinline__ int win_dest(int n) {
    const int hh = n >> 7; const bool rope = (hh < 10) || (hh >= 12 && hh < 48 && ((hh - 12) % 12) < 8);
    if (!rope) return n;
    const int c = n & 127, half = c >> 6, j = c & 63;
    return (n & ~127) + 32 * (j >> 4) + 8 * ((j >> 2) & 3) + 4 * half + (j & 3);
}
__device__ __forceinline__ void p0_transpose_item(const float* W, int K, int N, bf16* WT, int pitch, int koff, bool perm, LAS float* scr, int item, int lane) {
    const int nblk = N / 32, kb = item / nblk, nb = item % nblk, k0 = 64 * kb, n0 = 32 * nb;
    float t_[32];
#pragma unroll
    for (int i = 0; i < 32; ++i) { const int kk = 2 * i + (lane >> 5); t_[i] = W[(size_t)(k0 + kk) * N + n0 + (lane & 31)]; }
#pragma unroll
    for (int i = 0; i < 32; ++i) { const int kk = 2 * i + (lane >> 5); scr[kk * 33 + (lane & 31)] = t_[i]; }
    asm volatile("s_waitcnt lgkmcnt(0)" ::: "memory");
    const int c = lane & 7;
#pragma unroll
    for (int j = 0; j < 4; ++j) { const int n = (lane >> 3) + 8 * j; const LAS float* s = scr + (8 * c) * 33 + n;
        v4u o; o.x = pk2(s[0 * 33], s[1 * 33]); o.y = pk2(s[2 * 33], s[3 * 33]); o.z = pk2(s[4 * 33], s[5 * 33]); o.w = pk2(s[6 * 33], s[7 * 33]);
        const int dst = perm ? win_dest(n0 + n) : (n0 + n);
        *(v4u*)(WT + (size_t)dst * pitch + koff + k0 + 8 * c) = o; }
    asm volatile("s_waitcnt lgkmcnt(0)" ::: "memory");
}
#define RLX_AGENT __ATOMIC_RELAXED, __HIP_MEMORY_SCOPE_AGENT
#define XB_TMO      128
#define XB_XCNT(j)  (256  + 64 * (j))
#define XB_XSUB(j)  (1280 + 64 * (j))
#define XB_XGEN(j)  (2304 + 64 * (j))
#define XB_TOP      3328
#define XB_TOPGEN   3392
#define XCD_BAR_WORDS 3456
#define XB_SPIN_CAP (1u << 18)

__device__ __forceinline__ unsigned xb_ld(unsigned* p)              { return __hip_atomic_load(p, __ATOMIC_RELAXED, __HIP_MEMORY_SCOPE_AGENT); }
__device__ __forceinline__ unsigned xb_add(unsigned* p, unsigned v) { return __hip_atomic_fetch_add(p, v, __ATOMIC_RELAXED, __HIP_MEMORY_SCOPE_AGENT); }
__device__ __forceinline__ unsigned xb_xcc_id() { return (unsigned)__builtin_amdgcn_s_getreg((3 << 11) | 20) & 0xFu; }
#define XB_SPIN(cond, bar) do { unsigned _sp = 0; while (cond) { __builtin_amdgcn_s_sleep(1); \
    if ((++_sp & 255u) == 0u) { if (xb_ld(&(bar)[XB_TMO])) break; if (_sp > XB_SPIN_CAP) { atomicAdd(&(bar)[XB_TMO], 1u); break; } } } } while (0)

struct XcdBarrier {
    unsigned* bar; unsigned x;
    volatile LAS unsigned* st;
};

__device__ __forceinline__ XcdBarrier xcd_barrier_post(unsigned* bar, volatile LAS unsigned* st) {
    XcdBarrier b; b.bar = bar; b.x = xb_xcc_id(); b.st = st;
    if (threadIdx.x == 0) (void)xb_add(&bar[XB_XCNT(b.x)], 1u);
    return b;
}
__device__ __forceinline__ void xcd_barrier_complete(unsigned* bar, unsigned x, unsigned& nloc, unsigned& nx) {
    const unsigned G = gridDim.x * gridDim.y * gridDim.z;
    unsigned sum, cnt, mine, sp = 0u;
    for (;;) {
        sum = 0u; cnt = 0u; mine = 0u;
#pragma unroll
        for (unsigned j = 0; j < 16; ++j) { const unsigned c = xb_ld(&bar[XB_XCNT(j)]); sum += c; cnt += (c > 0u) ? 1u : 0u; mine = (j == x) ? c : mine; }
        if (sum == G) break;
        __builtin_amdgcn_s_sleep(1);
        if ((++sp & 255u) == 0u) { if (xb_ld(&bar[XB_TMO])) break; if (sp > XB_SPIN_CAP) { atomicAdd(&bar[XB_TMO], 1u); break; } }
    }
    nloc = mine > 0u ? mine : 1u; nx = cnt > 0u ? cnt : 1u;
}

__device__ __forceinline__ void xcd_barrier(const XcdBarrier& b) {
    asm volatile("s_waitcnt vmcnt(0)" ::: "memory");
    __syncthreads();
    if (threadIdx.x == 0) {
        unsigned* bar = b.bar;
        __builtin_amdgcn_s_waitcnt(0);
        unsigned nloc = b.st[0], nx = b.st[1];
        if (nloc == 0u) { xcd_barrier_complete(bar, b.x, nloc, nx); b.st[0] = nloc; b.st[1] = nx; }
        const unsigned old = xb_add(&bar[XB_XSUB(b.x)], 1u);
        const unsigned gen = old / nloc;
        if (old + 1u == (gen + 1u) * nloc) {
            __builtin_amdgcn_fence(__ATOMIC_RELEASE, "agent");
            asm volatile("s_waitcnt vmcnt(0)" ::: "memory");
            const unsigned og = xb_add(&bar[XB_TOP], 1u);
            const unsigned tg = og / nx;
            if (og + 1u == (tg + 1u) * nx) xb_add(&bar[XB_TOPGEN], 1u);
            else XB_SPIN(xb_ld(&bar[XB_TOPGEN]) == tg, bar);
            __builtin_amdgcn_fence(__ATOMIC_ACQUIRE, "agent");
            xb_add(&bar[XB_XGEN(b.x)], 1u);
            asm volatile("s_waitcnt vmcnt(0)" ::: "memory");
        } else {
            XB_SPIN(xb_ld(&bar[XB_XGEN(b.x)]) == gen, bar);
            __builtin_amdgcn_fence(__ATOMIC_ACQUIRE, "agent");
            asm volatile("s_waitcnt vmcnt(0)" ::: "memory");
        }
    }
    __syncthreads();
}

struct Args { const float* in[13]; float* out; unsigned char* ws; int cg_seams; int pad; };

__device__ __forceinline__ void load_row_bf16(const bf16* row, int lane, f32x4 (&v)[4]) {
#pragma unroll
    for (int j = 0; j < 4; ++j) { const v2u w = __builtin_nontemporal_load((const v2u*)(row + 4 * lane + 256 * j));
        v[j] = (f32x4){__builtin_bit_cast(float, w.x << 16), __builtin_bit_cast(float, w.x & 0xffff0000u), __builtin_bit_cast(float, w.y << 16), __builtin_bit_cast(float, w.y & 0xffff0000u)}; }
}
__device__ __forceinline__ void store_row_bf16(bf16* row, int lane, const f32x4 (&v)[4]) {
#pragma unroll
    for (int j = 0; j < 4; ++j) { v2u w; w.x = pk2(v[j][0], v[j][1]); w.y = pk2(v[j][2], v[j][3]); *(v2u*)(row + 4 * lane + 256 * j) = w; }
}
__device__ __forceinline__ float sumsq4(const f32x4 (&v)[4]) {
    float s = 0.f;
#pragma unroll
    for (int j = 0; j < 4; ++j) s += (v[j][0] * v[j][0] + v[j][1] * v[j][1]) + (v[j][2] * v[j][2] + v[j][3] * v[j][3]);
    return wave_sum(s);
}

#define KARG(i) (((const float* const volatile __attribute__((address_space(4)))*)__builtin_amdgcn_kernarg_segment_ptr())[i])
#define WSB() ((unsigned char*)KARG(14))
__global__ void __launch_bounds__(NWAVES * 64, 2) fwd_mega(Args args) {
    extern __shared__ __attribute__((aligned(16))) unsigned char lds_raw[];
    cg::grid_group grid = cg::this_grid();
    LAS unsigned char* lds = (LAS unsigned char*)lds_raw;
    const int tid = threadIdx.x, wave = __builtin_amdgcn_readfirstlane(tid >> 6);
#define FRESH_LANE() int lane = threadIdx.x & 63; asm volatile("" : "+v"(lane)); int gwl = gw; asm volatile("" : "+s"(gwl))
    const int G = gridDim.x, gw = blockIdx.x * NWAVES + wave, NGW = G * NWAVES;
    if (tid < 64) ((LAS unsigned*)(lds + RING_BYTES))[tid] = 0u;
    __syncthreads();
    const XcdBarrier bar = xcd_barrier_post((unsigned*)KARG(14), (volatile LAS unsigned*)(lds + RING_BYTES + 32));
    const int cg_seams = ((const volatile int __attribute__((address_space(4)))*)__builtin_amdgcn_kernarg_segment_ptr())[30];
#define GRID_BAR() do { if (cg_seams) grid.sync(); else xcd_barrier(bar); } while (0)
    {
        FRESH_LANE();
        unsigned char* ws = WSB();
        const float* w_in = KARG(2); const float* w_a = KARG(4); const float* w_b = KARG(5); const float* w_o = KARG(6); const float* w_1 = KARG(11); const float* w_2 = KARG(12);
        bf16* Win_t = (bf16*)(ws + WS_WIN); bf16* Wa_t = (bf16*)(ws + WS_WA); bf16* Wo_t = (bf16*)(ws + WS_WO); bf16* W1_t = (bf16*)(ws + WS_W1); bf16* W2_t = (bf16*)(ws + WS_W2);
        float* ropeC = (float*)(ws + WS_RC); float* ropeS = (float*)(ws + WS_RS);
        LAS float* scr = (LAS float*)(lds + wave * 16384);
        constexpr int I_IN = (D / 64) * (DIN / 32), I_A = (D / 64) * (D / 32), I_B = (512 / 64) * (D / 32), I_O = I_A, I_1 = (D / 64) * (DFF / 32), I_2 = (DFF / 64) * (D / 32);
        constexpr int NITEMS = I_IN + I_A + I_B + I_O + I_1 + I_2;
        for (int it = gwl; it < NITEMS; it += NGW) {
            int r = it;
            if (r < I_IN) { p0_transpose_item(w_in, D, DIN, Win_t, D, 0, true, scr, r, lane); continue; } r -= I_IN;
            if (r < I_A) { p0_transpose_item(w_a, D, D, Wa_t, 1536, 0, false, scr, r, lane); continue; } r -= I_A;
            if (r < I_B) { p0_transpose_item(w_b, 512, D, Wa_t, 1536, 1024, false, scr, r, lane); continue; } r -= I_B;
            if (r < I_O) { p0_transpose_item(w_o, D, D, Wo_t, D, 0, false, scr, r, lane); continue; } r -= I_O;
            if (r < I_1) { p0_transpose_item(w_1, D, DFF, W1_t, D, 0, false, scr, r, lane); continue; } r -= I_1;
            p0_transpose_item(w_2, DFF, D, W2_t, DFF, 0, false, scr, r, lane);
        }
    }
    for (int ck = 0; ck < NCHUNK; ++ck) {
        const int L = (ck < 2) ? 2048 : 4096;
#define XIN() ((ck < 2) ? KARG(0) + (size_t)ck * CH * D : KARG(1))
#define XOUT() ((float*)KARG(13) + (size_t)ck * CH * D)
#define WP(T, off) ((T*)(WSB() + (off)))
        { FRESH_LANE(); const float* xin = XIN(); const float* g1 = KARG(7); bf16* XN = WP(bf16, WS_XN); float* RS1 = WP(float, WS_RS1);
        f32x4 gv[4];
#pragma unroll
        for (int j = 0; j < 4; ++j) gv[j] = *(const f32x4*)(g1 + 4 * lane + 256 * j);
        for (int m = gwl * RB; m < CH; m += NGW * RB) {
            f32x4 v[RB][4];
#pragma unroll
            for (int k = 0; k < RB; ++k)
#pragma unroll
                for (int j = 0; j < 4; ++j) v[k][j] = __builtin_nontemporal_load((const f32x4*)(xin + (size_t)(m + k) * D + 4 * lane + 256 * j));
#pragma unroll
            for (int k = 0; k < RB; ++k) {
                const float rs = 1.0f / sqrtf(sumsq4(v[k]) * (1.0f / D) + EPS);
#pragma unroll
                for (int j = 0; j < 4; ++j) v[k][j] = v[k][j] * rs * gv[j];
                store_row_bf16(XN + (size_t)(m + k) * D, lane, v[k]);
                if (lane == 0) RS1[m + k] = rs;
            }
        }
        }
        GRID_BAR();
        { bf16* XN = WP(bf16, WS_XN); bf16* Win_t = WP(bf16, WS_WIN); bf16* Z = WP(bf16, WS_Z); float* ropeC = WP(float, WS_RC); float* ropeS = WP(float, WS_RS);
          pg8::Gemm g{XN, Win_t, CH, DIN, D}; pg8::StaticOrder S; S.init(CH, DIN, G, (int)blockIdx.x); S.wgm = 4;
          pg8::Epi<0> E{Z, DIN, nullptr, ropeC, ropeS, L - 1, 0.088388347648318440f * 1.4426950408889634f};
          pg8::gemm_phase<pg8::Epi<0>, pg8::StaticOrder, true, true>(lds, g, S, E); }
        GRID_BAR();
        {
            const float* sink = KARG(3); bf16* Z = WP(bf16, WS_Z); bf16* OA = WP(bf16, WS_OAB); bf16* OB3 = WP(bf16, WS_OB3); float* LSE = WP(float, WS_LSE);
            const int vcu = (G % 8 == 0) ? ((int)blockIdx.x % 8) * (G / 8) + (int)blockIdx.x / 8 : (int)blockIdx.x;
            att::attn_items<1>(lds, Z, vcu, 1024, G, L, sink, OA, 0, 1536, nullptr, 0);
            att::attn_items<2>(lds, Z, vcu, 1536, G, L, sink, OB3, (size_t)CH * 512, 512, LSE, (size_t)CH * 4);
        }
        GRID_BAR();
        { FRESH_LANE(); bf16* OB3 = WP(bf16, WS_OB3); float* LSE = WP(float, WS_LSE); bf16* OBM = WP(bf16, WS_OAB) + 1024;
        const int hd = lane >> 4;
        for (int m0 = gwl * RB; m0 < CH; m0 += NGW * RB) {
            v4u a[RB], b[RB], c[RB]; float l0[RB], l1[RB], l2[RB];
#pragma unroll
            for (int k = 0; k < RB; ++k) { const size_t m = m0 + k;
                l0[k] = LSE[m * 4 + hd]; l1[k] = LSE[(size_t)CH * 4 + m * 4 + hd]; l2[k] = LSE[(size_t)2 * CH * 4 + m * 4 + hd];
                a[k] = __builtin_nontemporal_load((const v4u*)(OB3 + m * 512 + 8 * lane)); b[k] = __builtin_nontemporal_load((const v4u*)(OB3 + (size_t)CH * 512 + m * 512 + 8 * lane)); c[k] = __builtin_nontemporal_load((const v4u*)(OB3 + (size_t)2 * CH * 512 + m * 512 + 8 * lane)); }
#pragma unroll
            for (int k = 0; k < RB; ++k) {
                const float mx = fmaxf(l0[k], fmaxf(l1[k], l2[k]));
                float e0 = __builtin_amdgcn_exp2f(l0[k] - mx), e1 = __builtin_amdgcn_exp2f(l1[k] - mx), e2 = __builtin_amdgcn_exp2f(l2[k] - mx);
                const float inv = 1.0f / (e0 + e1 + e2); e0 *= inv; e1 *= inv; e2 *= inv;
                v4u o;
#define MRG(x) pk2(e0 * pg8::bf_lo(a[k].x) + e1 * pg8::bf_lo(b[k].x) + e2 * pg8::bf_lo(c[k].x), e0 * pg8::bf_hi(a[k].x) + e1 * pg8::bf_hi(b[k].x) + e2 * pg8::bf_hi(c[k].x))
                o.x = MRG(x); o.y = MRG(y); o.z = MRG(z); o.w = MRG(w);
#undef MRG
                *(v4u*)(OBM + (size_t)(m0 + k) * 1536 + 8 * lane) = o;
            }
        }
        }
        GRID_BAR();
        { bf16* OAB = WP(bf16, WS_OAB); bf16* Wab_t = WP(bf16, WS_WA); bf16* Gb = WP(bf16, WS_G); bf16* Z = WP(bf16, WS_Z);
          pg8::Gemm g{OAB, Wab_t, CH, D, 1536}; pg8::StaticOrder S; S.init(CH, D, G, (int)blockIdx.x);
          pg8::Epi<1> E{Gb, D, Z + 56 * pg8::ZH, nullptr, nullptr, 0, 1.f};
          pg8::gemm_phase<pg8::Epi<1>, pg8::StaticOrder, true, true>(lds, g, S, E); }
        GRID_BAR();
        { bf16* Gb = WP(bf16, WS_G); bf16* Wo_t = WP(bf16, WS_WO); bf16* MIX = WP(bf16, WS_MIX);
          pg8::Gemm g{Gb, Wo_t, CH, D, D}; pg8::StaticOrder S; S.init(CH, D, G, (int)blockIdx.x);
          pg8::Epi<3> E{MIX, D, nullptr, nullptr, nullptr, 0, 1.f};
          pg8::gemm_phase<pg8::Epi<3>, pg8::StaticOrder, true, true>(lds, g, S, E); }
        GRID_BAR();
        { FRESH_LANE(); const float* g1 = KARG(7); const float* g2 = KARG(8); const float* g3 = KARG(9); bf16* MIX = WP(bf16, WS_MIX); bf16* XN = WP(bf16, WS_XN); bf16* X1B = WP(bf16, WS_X1B); const float* RS1 = WP(float, WS_RS1);
        f32x4 gi1[4], gv2[4], gv3[4];
#pragma unroll
        for (int j = 0; j < 4; ++j) { const f32x4 t = *(const f32x4*)(g1 + 4 * lane + 256 * j); gi1[j] = (f32x4){1.0f / t[0], 1.0f / t[1], 1.0f / t[2], 1.0f / t[3]};
            gv2[j] = *(const f32x4*)(g2 + 4 * lane + 256 * j); gv3[j] = *(const f32x4*)(g3 + 4 * lane + 256 * j); }
        for (int m = gwl * RB; m < CH; m += NGW * RB) {
            f32x4 v[RB][4], x[RB][4]; float ir[RB];
#pragma unroll
            for (int k = 0; k < RB; ++k) { load_row_bf16(MIX + (size_t)(m + k) * D, lane, v[k]); load_row_bf16(XN + (size_t)(m + k) * D, lane, x[k]); ir[k] = 1.0f / RS1[m + k]; }
#pragma unroll
            for (int k = 0; k < RB; ++k) {
                const float rs = 1.0f / sqrtf(sumsq4(v[k]) * (1.0f / D) + EPS);
#pragma unroll
                for (int j = 0; j < 4; ++j) x[k][j] = x[k][j] * ir[k] * gi1[j] + v[k][j] * rs * gv2[j];
                store_row_bf16(X1B + (size_t)(m + k) * D, lane, x[k]);
                const float rs2 = 1.0f / sqrtf(sumsq4(x[k]) * (1.0f / D) + EPS);
#pragma unroll
                for (int j = 0; j < 4; ++j) x[k][j] = x[k][j] * rs2 * gv3[j];
                store_row_bf16(XN + (size_t)(m + k) * D, lane, x[k]);
            }
        }
        }
        GRID_BAR();
        { bf16* XN = WP(bf16, WS_XN); bf16* W1_t = WP(bf16, WS_W1); bf16* U = WP(bf16, WS_U);
          pg8::Gemm g{XN, W1_t, CH, DFF, D}; pg8::StaticOrder S; S.init(CH, DFF, G, (int)blockIdx.x);
          pg8::Epi<4> E{U, DFF, nullptr, nullptr, nullptr, 0, 1.f};
          pg8::gemm_phase<pg8::Epi<4>, pg8::StaticOrder, true, true>(lds, g, S, E); }
        GRID_BAR();
        { bf16* U = WP(bf16, WS_U); bf16* W2_t = WP(bf16, WS_W2); bf16* Fb = WP(bf16, WS_F);
          pg8::Gemm g{U, W2_t, CH, D, DFF}; pg8::StaticOrder S; S.init(CH, D, G, (int)blockIdx.x);
          pg8::Epi<3> E{Fb, D, nullptr, nullptr, nullptr, 0, 1.f};
          pg8::gemm_phase<pg8::Epi<3>, pg8::StaticOrder, true, true>(lds, g, S, E); }
        GRID_BAR();
        { FRESH_LANE(); float* xout = XOUT(); const float* g4 = KARG(10); bf16* Fb = WP(bf16, WS_F); bf16* X1B = WP(bf16, WS_X1B);
        f32x4 gv[4];
#pragma unroll
        for (int j = 0; j < 4; ++j) gv[j] = *(const f32x4*)(g4 + 4 * lane + 256 * j);
        for (int m = gwl * RB; m < CH; m += NGW * RB) {
            f32x4 v[RB][4], x[RB][4];
#pragma unroll
            for (int k = 0; k < RB; ++k) { load_row_bf16(Fb + (size_t)(m + k) * D, lane, v[k]); load_row_bf16(X1B + (size_t)(m + k) * D, lane, x[k]); }
#pragma unroll
            for (int k = 0; k < RB; ++k) {
                const float rs = 1.0f / sqrtf(sumsq4(v[k]) * (1.0f / D) + EPS);
#pragma unroll
                for (int j = 0; j < 4; ++j) __builtin_nontemporal_store(x[k][j] + v[k][j] * rs * gv[j], (f32x4*)(xout + (size_t)(m + k) * D + 4 * lane + 256 * j));
            }
        }
        }
    }
}

extern "C" void kernel_launch(void* const* d_in, const int* in_sizes, int n_in, void* d_out, int out_size, void* d_ws, size_t ws_size, hipStream_t stream) {
    static int grid = 0;
    if (grid == 0) {
        if (n_in != 13 || out_size != TOK * D || ws_size < WS_END) { fprintf(stderr, "kernel_launch: unexpected shapes (n_in %d out %d ws %zu)\n", n_in, out_size, ws_size); grid = -1; return; }
        int dev = 0, cus = 0, per_cu = 0;
        hipGetDevice(&dev); hipDeviceGetAttribute(&cus, hipDeviceAttributeMultiprocessorCount, dev);
        if (hipFuncSetAttribute((const void*)fwd_mega, hipFuncAttributeMaxDynamicSharedMemorySize, LDS_BYTES) != hipSuccess) { fprintf(stderr, "kernel_launch: hipFuncSetAttribute failed\n"); grid = -1; return; }
        if (hipOccupancyMaxActiveBlocksPerMultiprocessor(&per_cu, (const void*)fwd_mega, NWAVES * 64, LDS_BYTES) != hipSuccess || per_cu < 1) { fprintf(stderr, "kernel_launch: occupancy query says %d\n", per_cu); per_cu = 1; }
        (void)hipGetLastError();
        grid = cus * 1;
    }
    if (grid < 0) return;
    if (hipMemsetAsync(d_ws, 0, 65536, stream) != hipSuccess) { fprintf(stderr, "kernel_launch: memset failed\n"); return; }
    Args a{};
    for (int i = 0; i < 13; ++i) a.in[i] = (const float*)d_in[i];
    a.out = (float*)d_out; a.ws = (unsigned char*)d_ws; a.cg_seams = 0;
    void* kargs[] = {&a};
    hipError_t e = hipLaunchCooperativeKernel((const void*)fwd_mega, dim3(grid), dim3(NWAVES * 64), kargs, LDS_BYTES, stream);
    if (e != hipSuccess) fprintf(stderr, "kernel_launch: cooperative launch failed: %s (grid %d)\n", hipGetErrorString(e), grid);
}
```
